# Optimizing an MI355X kernel written in HIP

```python
import math
import jax, jax.numpy as jnp
from jax import lax
import numpy as np

D_MODEL = 1024
BATCH = 8
SEQ = 4096
DEPTH = 4

N_MIXERS = 3
N_MLA_LAYERS = (DEPTH + 2) // 3
N_RET_LAYERS = (DEPTH + 1) // 3
N_GLA_LAYERS = DEPTH // 3

DEEPNORM_ALPHA = (2.0 * DEPTH) ** 0.25
DEEPNORM_BETA = (8.0 * DEPTH) ** -0.25
LN_EPS = 1e-5
RMS_EPS = 1e-6

FFN_HIDDEN = -(-8 * D_MODEL // (3 * 256)) * 256

ROPE_BASE = 10000.0

MLA_HEADS = 8
MLA_NOPE = 128
MLA_ROPE = 64
MLA_V = 128
MLA_Q_RANK = 512
MLA_KV_RANK = 256
MLA_Q_BLOCK = 128

RET_HEADS = 4
RET_QK_DIM = D_MODEL // RET_HEADS
RET_V_DIM = 2 * RET_QK_DIM
RET_CHUNK = 128

GLA_HEADS = 4
GLA_KEY_DIM = (D_MODEL // 2) // GLA_HEADS
GLA_V_DIM = D_MODEL // GLA_HEADS
GLA_GATE_RANK = 16
GLA_TAU = 16.0
GLA_CHUNK = 64

kernel_name = "hybrid_mla_retention_gla_deepnorm_encoder"


def layer_norm(x, g, b):
    xf = x.astype(jnp.float32)
    mu = jnp.mean(xf, axis=-1, keepdims=True)
    var = jnp.mean(jnp.square(xf - mu), axis=-1, keepdims=True)
    return ((xf - mu) * lax.rsqrt(var + LN_EPS) * g.astype(jnp.float32) + b.astype(jnp.float32)).astype(x.dtype)


def rms_norm(x, g):
    xf = x.astype(jnp.float32)
    ms = jnp.mean(jnp.square(xf), axis=-1, keepdims=True)
    return (xf * lax.rsqrt(ms + RMS_EPS) * g.astype(jnp.float32)).astype(x.dtype)


def apply_rotary(x, positions):
    d = x.shape[-1]
    inv_freq = ROPE_BASE ** (-jnp.arange(0, d, 2, dtype=jnp.float32) / d)
    ang = positions.astype(jnp.float32)[..., None] * inv_freq
    cos = jnp.cos(ang)[:, :, None, :]
    sin = jnp.sin(ang)[:, :, None, :]
    xf = x.astype(jnp.float32)
    x1, x2 = xf[..., : d // 2], xf[..., d // 2:]
    return jnp.concatenate([x1 * cos - x2 * sin, x1 * sin + x2 * cos], axis=-1).astype(x.dtype)


def flip_seq(a):
    return jnp.flip(a, axis=1)


def mla_mixer(x, positions, w_down, q_norm, w_uq, kv_norm, w_ukv, w_o):
    B, S, _ = x.shape
    H = MLA_HEADS
    down = x @ w_down
    c_q = down[..., :MLA_Q_RANK]
    c_kv = down[..., MLA_Q_RANK:MLA_Q_RANK + MLA_KV_RANK]
    k_rope = down[..., MLA_Q_RANK + MLA_KV_RANK:]
    q = (rms_norm(c_q, q_norm) @ w_uq).reshape(B, S, H, MLA_NOPE + MLA_ROPE)
    q_nope = q[..., :MLA_NOPE]
    q_rope = apply_rotary(q[..., MLA_NOPE:], positions)
    kv = (rms_norm(c_kv, kv_norm) @ w_ukv).reshape(B, S, H, MLA_NOPE + MLA_V)
    k_nope = kv[..., :MLA_NOPE]
    v = kv[..., MLA_NOPE:]
    k_rope = apply_rotary(k_rope[:, :, None, :], positions)[:, :, 0, :]
    scale = (MLA_NOPE + MLA_ROPE) ** -0.5
    nb = S // MLA_Q_BLOCK
    qn_blocks = jnp.moveaxis(q_nope.reshape(B, nb, MLA_Q_BLOCK, H, MLA_NOPE), 1, 0)
    qr_blocks = jnp.moveaxis(q_rope.reshape(B, nb, MLA_Q_BLOCK, H, MLA_ROPE), 1, 0)

    def attend(blk):
        qn_b, qr_b = blk
        s = (jnp.einsum('bqhd,bkhd->bhqk', qn_b, k_nope)
             + jnp.einsum('bqhr,bkr->bhqk', qr_b, k_rope)).astype(jnp.float32) * scale
        p = jax.nn.softmax(s, axis=-1)
        return jnp.einsum('bhqk,bkhd->bqhd', p.astype(v.dtype), v)

    o = lax.map(attend, (qn_blocks, qr_blocks))
    o = jnp.moveaxis(o, 0, 1).reshape(B, S, H * MLA_V)
    return o @ w_o


def retention_chunked(q, k, v, log_gamma, strict):
    B, S, H, DK = q.shape
    DV = v.shape[-1]
    C = RET_CHUNK
    N = S // C
    qc = q.reshape(B, N, C, H, DK)
    kc = k.reshape(B, N, C, H, DK)
    vc = v.reshape(B, N, C, H, DV)
    lg = log_gamma.astype(jnp.float32)
    idx = jnp.arange(C, dtype=jnp.float32)
    diff = idx[:, None] - idx[None, :]
    mask = (diff > 0) if strict else (diff >= 0)
    dmat = jnp.where(mask[None], jnp.exp(jnp.maximum(diff, 0.0)[None] * lg[:, None, None]), 0.0)
    scores = jnp.einsum('bnihd,bnjhd->bnhij', qc, kc) * dmat[None, None]
    intra = jnp.einsum('bnhij,bnjhe->bnihe', scores, vc)
    q_decay = jnp.exp((idx[:, None] + 1.0) * lg[None])
    k_decay = jnp.exp((C - 1.0 - idx)[:, None] * lg[None])
    chunk_decay = jnp.exp(C * lg)

    def step(state, xs):
        q_n, k_n, v_n = xs
        cross = jnp.einsum('bihd,bhde->bihe', q_n, state) * q_decay[None, :, :, None]
        state = (state * chunk_decay[None, :, None, None]
                 + jnp.einsum('bjhd,bjhe->bhde', k_n * k_decay[None, :, :, None], v_n))
        return state, cross

    state0 = jnp.zeros((B, H, DK, DV), jnp.float32)
    _, cross = lax.scan(step, state0, (jnp.moveaxis(qc, 1, 0), jnp.moveaxis(kc, 1, 0), jnp.moveaxis(vc, 1, 0)))
    cross = jnp.moveaxis(cross, 0, 1)
    return (intra + cross).reshape(B, S, H, DV)


def retention_mixer(x, positions, w_in, decay_logit, gn_w, gn_b, w_o):
    B, S, _ = x.shape
    H, DK, DV = RET_HEADS, RET_QK_DIM, RET_V_DIM
    proj = x @ w_in
    q = proj[..., : H * DK].reshape(B, S, H, DK)
    k = proj[..., H * DK: 2 * H * DK].reshape(B, S, H, DK)
    v = proj[..., 2 * H * DK: 2 * H * DK + H * DV].reshape(B, S, H, DV).astype(jnp.float32)
    g = proj[..., 2 * H * DK + H * DV:]
    q = apply_rotary(q, positions).astype(jnp.float32)
    k = apply_rotary(k, positions).astype(jnp.float32) * (DK ** -0.5)
    log_gamma = jax.nn.log_sigmoid(decay_logit.astype(jnp.float32))
    y = (retention_chunked(q, k, v, log_gamma[0], False)
         + flip_seq(retention_chunked(flip_seq(q), flip_seq(k), flip_seq(v), log_gamma[1], True)))
    mu = jnp.mean(y, axis=-1, keepdims=True)
    var = jnp.mean(jnp.square(y - mu), axis=-1, keepdims=True)
    y = (y - mu) * lax.rsqrt(var + LN_EPS)
    y = y.reshape(B, S, H * DV) * gn_w.astype(jnp.float32) + gn_b.astype(jnp.float32)
    return (jax.nn.silu(g) * y.astype(x.dtype)) @ w_o


def gla_chunked(q, k, v, log_alpha, strict):
    B, S, H, DK = q.shape
    DV = v.shape[-1]
    C = GLA_CHUNK
    N = S // C
    qc = q.reshape(B, N, C, H, DK)
    kc = k.reshape(B, N, C, H, DK)
    vc = v.reshape(B, N, C, H, DV)
    b = jnp.cumsum(log_alpha.reshape(B, N, C, H, DK), axis=2)
    q_in = qc * jnp.exp(b)
    k_in = kc * jnp.exp(-b)
    idx = jnp.arange(C)
    mask = (idx[:, None] > idx[None, :]) if strict else (idx[:, None] >= idx[None, :])
    scores = jnp.where(mask, jnp.einsum('bnihd,bnjhd->bnhij', q_in, k_in), 0.0)
    intra = jnp.einsum('bnhij,bnjhe->bnihe', scores, vc)
    b_last = b[:, :, -1]
    k_state = kc * jnp.exp(b_last[:, :, None] - b)

    def step(state, xs):
        q_n, k_n, v_n, bl_n = xs
        cross = jnp.einsum('bihd,bhde->bihe', q_n, state)
        state = state * jnp.exp(bl_n)[..., None] + jnp.einsum('bjhd,bjhe->bhde', k_n, v_n)
        return state, cross

    state0 = jnp.zeros((B, H, DK, DV), jnp.float32)
    _, cross = lax.scan(step, state0, (jnp.moveaxis(q_in, 1, 0), jnp.moveaxis(k_state, 1, 0),
                                       jnp.moveaxis(vc, 1, 0), jnp.moveaxis(b_last, 1, 0)))
    cross = jnp.moveaxis(cross, 0, 1)
    return (intra + cross).reshape(B, S, H, DV)


def gla_mixer(x, w_in, w_a1, w_a2, b_a, norm_g, w_o):
    B, S, _ = x.shape
    H, DK, DV = GLA_HEADS, GLA_KEY_DIM, GLA_V_DIM
    hk, hv = H * DK, H * DV
    proj = x @ w_in
    q = proj[..., :hk].reshape(B, S, H, DK).astype(jnp.float32) * (DK ** -0.5)
    k = proj[..., hk:2 * hk].reshape(B, S, H, DK).astype(jnp.float32)
    v = proj[..., 2 * hk:2 * hk + hv].reshape(B, S, H, DV).astype(jnp.float32)
    r = proj[..., 2 * hk + hv:]

    def log_gate(z):
        logits = ((x @ w_a1[z]) @ w_a2[z] + b_a[z]).astype(jnp.float32)
        return (jax.nn.log_sigmoid(logits) / GLA_TAU).reshape(B, S, H, DK)

    y = (gla_chunked(q, k, v, log_gate(0), False)
         + flip_seq(gla_chunked(flip_seq(q), flip_seq(k), flip_seq(v), flip_seq(log_gate(1)), True)))
    y = rms_norm(y, norm_g).reshape(B, S, hv)
    return (jax.nn.silu(r) * y.astype(x.dtype)) @ w_o


def swiglu_ffn(x, w_in, w_out):
    gate, up = jnp.split(x @ w_in, 2, axis=-1)
    return (jax.nn.silu(gate) * up) @ w_out


def setup_inputs(seed: int = 0) -> dict:
    key = jax.random.key(seed)
    keys = iter(jax.random.split(key, 40))
    f32 = jnp.float32

    def w(shape, fan_in, gain=1.0):
        return jax.random.normal(next(keys), shape, f32) * (gain * fan_in ** -0.5)

    def gain_(shape):
        return 1.0 + 0.02 * jax.random.normal(next(keys), shape, f32)

    def bias_(shape):
        return 0.02 * jax.random.normal(next(keys), shape, f32)

    D, F = D_MODEL, FFN_HIDDEN
    nA, nB, nC = N_MLA_LAYERS, N_RET_LAYERS, N_GLA_LAYERS
    beta = DEEPNORM_BETA

    x = jax.random.normal(next(keys), (BATCH, SEQ, D), f32)
    offsets = jax.random.randint(next(keys), (BATCH, 1), 0, SEQ, dtype=jnp.int32)
    positions = (jnp.arange(SEQ, dtype=jnp.int32)[None, :] + offsets).astype(jnp.int32)

    ln_g = gain_((DEPTH, 2, D))
    ln_b = bias_((DEPTH, 2, D))
    ffn_w_in = w((DEPTH, D, 2 * F), D, beta)
    ffn_w_out = w((DEPTH, F, D), F, beta)

    H = MLA_HEADS
    mla_w_down = w((nA, D, MLA_Q_RANK + MLA_KV_RANK + MLA_ROPE), D)
    mla_q_norm = gain_((nA, MLA_Q_RANK))
    mla_w_uq = w((nA, MLA_Q_RANK, H * (MLA_NOPE + MLA_ROPE)), MLA_Q_RANK)
    mla_kv_norm = gain_((nA, MLA_KV_RANK))
    mla_w_ukv = jnp.concatenate([w((nA, MLA_KV_RANK, H, MLA_NOPE), MLA_KV_RANK),
                                 w((nA, MLA_KV_RANK, H, MLA_V), MLA_KV_RANK, beta)],
                                axis=-1).reshape(nA, MLA_KV_RANK, H * (MLA_NOPE + MLA_V))
    mla_w_o = w((nA, H * MLA_V, D), H * MLA_V, beta)

    rq = RET_HEADS * RET_QK_DIM
    rv = RET_HEADS * RET_V_DIM
    ret_w_in = jnp.concatenate([w((nB, D, 2 * rq), D), w((nB, D, rv), D, beta), w((nB, D, rv), D)], axis=-1)
    base_logit = jnp.asarray(np.log(2.0 ** (5 + np.arange(RET_HEADS)) - 1.0), dtype=f32)
    ret_decay_logit = base_logit[None, None, :] + 0.01 * jax.random.normal(next(keys), (nB, 2, RET_HEADS), f32)
    ret_gn_w = gain_((nB, rv))
    ret_gn_b = bias_((nB, rv))
    ret_w_o = w((nB, rv, D), rv, beta)

    gk = GLA_HEADS * GLA_KEY_DIM
    gv = GLA_HEADS * GLA_V_DIM
    gla_w_in = jnp.concatenate([w((nC, D, 2 * gk), D), w((nC, D, gv), D, beta), w((nC, D, gv), D)], axis=-1)
    gla_w_a1 = w((nC, 2, D, GLA_GATE_RANK), D)
    gla_w_a2 = w((nC, 2, GLA_GATE_RANK, gk), GLA_GATE_RANK)
    gla_b_a = bias_((nC, 2, gk))
    gla_norm = gain_((nC, GLA_V_DIM))
    gla_w_o = w((nC, gv, D), gv, beta)

    return {"x": x, "positions": positions, "ln_g": ln_g, "ln_b": ln_b,
            "ffn_w_in": ffn_w_in, "ffn_w_out": ffn_w_out,
            "mla_w_down": mla_w_down, "mla_q_norm": mla_q_norm, "mla_w_uq": mla_w_uq,
            "mla_kv_norm": mla_kv_norm, "mla_w_ukv": mla_w_ukv, "mla_w_o": mla_w_o,
            "ret_w_in": ret_w_in, "ret_decay_logit": ret_decay_logit, "ret_gn_w": ret_gn_w,
            "ret_gn_b": ret_gn_b, "ret_w_o": ret_w_o,
            "gla_w_in": gla_w_in, "gla_w_a1": gla_w_a1, "gla_w_a2": gla_w_a2, "gla_b_a": gla_b_a,
            "gla_norm": gla_norm, "gla_w_o": gla_w_o}


def reference(x, positions, ln_g, ln_b, ffn_w_in, ffn_w_out,
              mla_w_down, mla_q_norm, mla_w_uq, mla_kv_norm, mla_w_ukv, mla_w_o,
              ret_w_in, ret_decay_logit, ret_gn_w, ret_gn_b, ret_w_o,
              gla_w_in, gla_w_a1, gla_w_a2, gla_b_a, gla_norm, gla_w_o):
    for i in range(DEPTH):
        kind = i % N_MIXERS
        j = i // N_MIXERS
        if kind == 0:
            y = mla_mixer(x, positions, mla_w_down[j], mla_q_norm[j], mla_w_uq[j],
                          mla_kv_norm[j], mla_w_ukv[j], mla_w_o[j])
        elif kind == 1:
            y = retention_mixer(x, positions, ret_w_in[j], ret_decay_logit[j],
                                ret_gn_w[j], ret_gn_b[j], ret_w_o[j])
        else:
            y = gla_mixer(x, gla_w_in[j], gla_w_a1[j], gla_w_a2[j], gla_b_a[j],
                          gla_norm[j], gla_w_o[j])
        x = layer_norm(DEEPNORM_ALPHA * x + y, ln_g[i, 0], ln_b[i, 0])
        x = layer_norm(DEEPNORM_ALPHA * x + swiglu_ffn(x, ffn_w_in[i], ffn_w_out[i]), ln_g[i, 1], ln_b[i, 1])
    return x
```

```cpp
#include <hip/hip_runtime.h>
#include <hip/hip_cooperative_groups.h>
#include <cstdio>
#include <cstdint>
namespace cg = cooperative_groups;
namespace pg8 {
#define PG8_LAS __attribute__((address_space(3)))
typedef unsigned short bf16_t;
typedef short bf16x8 __attribute__((ext_vector_type(8)));
typedef float f32x4 __attribute__((ext_vector_type(4)));
typedef unsigned u32x4 __attribute__((ext_vector_type(4)));
constexpr int BM = 256, BK = 64, HALF = 128, HTB = HALF * BK * 2  , STAGE_BYTES = 8 * HTB, NXCD = 8, WGM = 8;

__host__ __device__ __forceinline__ int lds_byte(int r, int c) { const int st = (r >> 4) * 2 + (c >> 5), rr = r & 15, cc = c & 31, ob = rr * 64 + cc * 2; return st * 1024 + (ob ^ (((ob >> 9) & 1) << 5)); }
__host__ __device__ __forceinline__ void stage_rc(int b, int& R, int& C) { const int st = b / 1024, sb = b % 1024, swz = sb ^ (((sb >> 9) & 1) << 5); R = (st >> 1) * 16 + swz / 64; C = (st & 1) * 32 + (swz % 64) / 2; }
__host__ __device__ __forceinline__ int perm32(int rho) { const int n = rho >> 4, i = rho & 15; return 8 * (i >> 2) + 4 * n + (i & 3); }

struct Unit { int pm, pn; };
struct Gemm { const bf16_t* A; const bf16_t* Bt; int M, N, K; };

struct StaticOrder {
    int nM, nN, nwg, G, c;
    __host__ __device__ void init(int M, int N, int G_, int c_) { nM = M / BM; nN = N / BM; nwg = nM * nN; G = G_; c = c_; }
    __host__ __device__ bool next(int i, Unit& u) const {
        const long L = (long)i * G + c; if (L >= nwg) return false;
        int wgid = (int)L; { const int q = nwg / NXCD, r = nwg % NXCD, xcd = wgid % NXCD, off = wgid / NXCD; wgid = (xcd < r ? xcd * (q + 1) : r * (q + 1) + (xcd - r) * q) + off; }
        const int nig = WGM * nN, gid = wgid / nig, fm = gid * WGM, gsz = (nM - fm) < WGM ? (nM - fm) : WGM;
        u.pm = fm + ((wgid % nig) % gsz); u.pn = (wgid % nig) / gsz; return true;
    }
    __device__ __forceinline__ void a_ready(const Unit&) const {}
    __device__ __forceinline__ void done(const Unit&) const {}
};

__device__ __forceinline__ unsigned cvt_pk_bf16(float lo, float hi) { unsigned r; asm volatile("v_cvt_pk_bf16_f32 %0, %1, %2" : "=v"(r) : "v"(lo), "v"(hi)); return r; }
typedef float f32x2 __attribute__((ext_vector_type(2)));
template <class Epi, class Sched, bool ALIGN_EPI = false, bool SP2 = false, bool F8 = false>
__device__ __forceinline__ void gemm_phase(PG8_LAS unsigned char* lds, const Gemm g, const Sched& S, const Epi& E, const int tid) {
    const int wid = __builtin_amdgcn_readfirstlane(tid >> 6), lane = tid & 63, wr = wid >> 2, wc = wid & 3, fr = lane & 15, fq = lane >> 4;
    const int K = g.K, nt = K / BK;
    unsigned voffA[2], voffB[2];
#pragma unroll
    for (int i = 0; i < 2; ++i) { int R, C; stage_rc(tid * 16 + i * 8192, R, C); const int Rb = Epi::PERM ? ((R & ~31) + perm32(R & 31)) : R;
        voffA[i] = (unsigned)(R * K + C) * 2u; voffB[i] = (unsigned)(Rb * K + C) * 2u; }
    const size_t kstep = (size_t)(BK * 2);
    const size_t hstep = (size_t)HALF * K * 2;
    const size_t tstep = 2 * hstep;
    const unsigned ldsw = (unsigned)wid * 1024u;
    const int aoff = lds_byte(wr * 64 + fr, fq * 8), boff = lds_byte(wc * 32 + fr, fq * 8);
#define PG8_SA(b, h) (((b) * 2 + (h)) * HTB)
#define PG8_SB(b, h) ((4 + (b) * 2 + (h)) * HTB)
#define PG8_STAGE(bufoff, gbase, voff) do { _Pragma("unroll") for (int _i = 0; _i < 2; ++_i) \
        __builtin_amdgcn_global_load_lds((const unsigned*)((const char*)(gbase) + (voff)[_i]), (PG8_LAS unsigned*)(lds + (bufoff) + ldsw + _i * 8192), 16, 0, 0); } while (0)
#define PG8_LDA(dst, b, h) do { if constexpr (F8) { _Pragma("unroll") for (int m = 0; m < 4; ++m) dst##8[m] = __builtin_shufflevector(*(const PG8_LAS v4i_*)(lds + PG8_SA(b, h) + aoff + m * 2048), *(const PG8_LAS v4i_*)(lds + PG8_SA(b, h) + aoff + m * 2048 + 1024), 0, 1, 2, 3, 4, 5, 6, 7); } \
        else { _Pragma("unroll") for (int m = 0; m < 4; ++m) _Pragma("unroll") for (int k = 0; k < 2; ++k) dst[m][k] = *(const PG8_LAS bf16x8*)(lds + PG8_SA(b, h) + aoff + m * 2048 + k * 1024); } } while (0)
#define PG8_LDB(dst, b, h) do { if constexpr (F8) { _Pragma("unroll") for (int n = 0; n < 2; ++n) dst##8[n] = __builtin_shufflevector(*(const PG8_LAS v4i_*)(lds + PG8_SB(b, h) + boff + n * 2048), *(const PG8_LAS v4i_*)(lds + PG8_SB(b, h) + boff + n * 2048 + 1024), 0, 1, 2, 3, 4, 5, 6, 7); } \
        else { _Pragma("unroll") for (int n = 0; n < 2; ++n) _Pragma("unroll") for (int k = 0; k < 2; ++k) dst[n][k] = *(const PG8_LAS bf16x8*)(lds + PG8_SB(b, h) + boff + n * 2048 + k * 1024); } } while (0)
#define PG8_MMA(ai, bj, At, Bt) do { __builtin_amdgcn_s_setprio(1); \
        if constexpr (F8) { _Pragma("unroll") for (int m = 0; m < 4; ++m) _Pragma("unroll") for (int n = 0; n < 2; ++n) \
                asm volatile("v_mfma_scale_f32_16x16x128_f8f6f4 %0, %1, %2, %0, %3, %3 op_sel_hi:[0,0,0]" : "+v"(acc[ai][bj][m][n]) : "v"(Bt##8[n]), "v"(At##8[m]), "v"(f8one)); \
        } else { _Pragma("unroll") for (int m = 0; m < 4; ++m) _Pragma("unroll") for (int n = 0; n < 2; ++n) _Pragma("unroll") for (int k = 0; k < 2; ++k) \
            acc[ai][bj][m][n] = __builtin_amdgcn_mfma_f32_16x16x32_bf16(Bt[n][k], At[m][k], acc[ai][bj][m][n], 0, 0, 0); } \
        __builtin_amdgcn_s_setprio(0); } while (0)
#define PG8_WAIT_V(n) asm volatile("s_waitcnt vmcnt(" #n ")" ::: "memory")
#define PG8_WAIT_L(n) asm volatile("s_waitcnt lgkmcnt(" #n ")" ::: "memory")
#define PG8_BAR __builtin_amdgcn_s_barrier()
#define PG8_SCHED __builtin_amdgcn_sched_barrier(0)
    Unit cur, nxt; int ui = 0;
    if (!S.next(0, cur)) return;
    f32x4 acc[2][2][4][2];
#pragma unroll
    for (int a = 0; a < 2; ++a)
#pragma unroll
        for (int b = 0; b < 2; ++b)
#pragma unroll
            for (int m = 0; m < 4; ++m)
#pragma unroll
                for (int n = 0; n < 2; ++n) acc[a][b][m][n] = (f32x4){0.f, 0.f, 0.f, 0.f};
    typedef int v4i_ __attribute__((ext_vector_type(4))); typedef int v8i_ __attribute__((ext_vector_type(8)));
    bf16x8 At[4][2], B0[2][2], B1[2][2]; v8i_ At8[4], B08[2], B18[2]; const int f8one = 0x7f7f7f7f;
    const char* cA = (const char*)g.A + (size_t)cur.pm * tstep; const char* cB = (const char*)g.Bt + (size_t)cur.pn * tstep;
    S.a_ready(cur);
    if constexpr (SP2) {
        PG8_STAGE(PG8_SB(0, 0), cB, voffB); PG8_STAGE(PG8_SB(0, 1), cB + hstep, voffB); PG8_STAGE(PG8_SA(0, 0), cA, voffA); PG8_STAGE(PG8_SA(0, 1), cA + hstep, voffA);
        if (wr == 1) PG8_BAR;
        PG8_WAIT_V(2); PG8_BAR;
        PG8_STAGE(PG8_SB(1, 0), cB + kstep, voffB); PG8_STAGE(PG8_SA(1, 0), cA + kstep, voffA); PG8_STAGE(PG8_SB(1, 1), cB + hstep + kstep, voffB);
        PG8_WAIT_V(6); PG8_BAR;
    } else {
        PG8_STAGE(PG8_SB(0, 0), cB, voffB); PG8_STAGE(PG8_SA(0, 0), cA, voffA); PG8_STAGE(PG8_SB(0, 1), cB + hstep, voffB); PG8_STAGE(PG8_SA(0, 1), cA + hstep, voffA);
        if (wr == 1) PG8_BAR;
        PG8_WAIT_V(4); PG8_BAR;
        PG8_STAGE(PG8_SB(1, 0), cB + kstep, voffB); PG8_STAGE(PG8_SA(1, 0), cA + kstep, voffA); PG8_STAGE(PG8_SB(1, 1), cB + hstep + kstep, voffB);
        PG8_WAIT_V(6); PG8_BAR;
    }
    for (;;) {
        const bool has_next = S.next(ui + 1, nxt);
        const char* nA = has_next ? (const char*)g.A + (size_t)nxt.pm * tstep : cA; const char* nB = has_next ? (const char*)g.Bt + (size_t)nxt.pn * tstep : cB;
        for (int t = 0; t < nt; t += 2) {
            const bool last = (t == nt - 2);
            const char* a1 = cA + (size_t)(t + 1) * kstep;
            const char* a2 = last ? nA : cA + (size_t)(t + 2) * kstep; const char* b2 = last ? nB : cB + (size_t)(t + 2) * kstep;
            const char* a3 = a2 + kstep; const char* b3 = b2 + kstep;
            if (last && has_next) S.a_ready(nxt);
            if constexpr (SP2) {
            PG8_LDB(B0, 0, 0); PG8_LDB(B1, 0, 1); PG8_SCHED; PG8_LDA(At, 0, 0); PG8_STAGE(PG8_SA(1, 1), a1 + hstep, voffA);
            PG8_WAIT_V(8); PG8_WAIT_L(0); PG8_BAR; PG8_MMA(0, 0, At, B0); PG8_MMA(0, 1, At, B1); PG8_BAR; PG8_SCHED;
            PG8_LDA(At, 0, 1); PG8_STAGE(PG8_SB(0, 0), b2, voffB); PG8_STAGE(PG8_SB(0, 1), b2 + hstep, voffB); PG8_STAGE(PG8_SA(0, 0), a2, voffA);
            PG8_WAIT_V(8); PG8_WAIT_L(0); PG8_BAR; PG8_MMA(1, 0, At, B0); PG8_MMA(1, 1, At, B1); PG8_BAR; PG8_SCHED;
            PG8_LDB(B0, 1, 0); PG8_LDB(B1, 1, 1); PG8_SCHED; PG8_LDA(At, 1, 0); PG8_STAGE(PG8_SA(0, 1), a2 + hstep, voffA);
            PG8_WAIT_V(8); PG8_WAIT_L(0); PG8_BAR; PG8_MMA(0, 0, At, B0); PG8_MMA(0, 1, At, B1); PG8_BAR; PG8_SCHED;
            PG8_LDA(At, 1, 1); PG8_STAGE(PG8_SB(1, 0), b3, voffB); PG8_STAGE(PG8_SB(1, 1), b3 + hstep, voffB); PG8_STAGE(PG8_SA(1, 0), a3, voffA);
            PG8_WAIT_V(8); PG8_WAIT_L(0); PG8_BAR; PG8_MMA(1, 0, At, B0); PG8_MMA(1, 1, At, B1); PG8_BAR; PG8_SCHED;
            } else {
            PG8_LDB(B0, 0, 0); PG8_SCHED; PG8_LDA(At, 0, 0); PG8_STAGE(PG8_SA(1, 1), a1 + hstep, voffA);
            PG8_WAIT_L(8); PG8_BAR; PG8_WAIT_L(0); PG8_MMA(0, 0, At, B0); PG8_BAR; PG8_SCHED;
            PG8_LDB(B1, 0, 1); PG8_STAGE(PG8_SB(0, 0), b2, voffB);
            PG8_BAR; PG8_WAIT_L(0); PG8_MMA(0, 1, At, B1); PG8_BAR;
            PG8_LDA(At, 0, 1); PG8_STAGE(PG8_SA(0, 0), a2, voffA);
            PG8_BAR; PG8_WAIT_L(0); PG8_MMA(1, 0, At, B0); PG8_BAR; PG8_SCHED;
            PG8_STAGE(PG8_SB(0, 1), b2 + hstep, voffB);
            PG8_WAIT_V(6); PG8_BAR; PG8_MMA(1, 1, At, B1); PG8_BAR;
            PG8_LDB(B0, 1, 0); PG8_SCHED; PG8_LDA(At, 1, 0); PG8_STAGE(PG8_SA(0, 1), a2 + hstep, voffA);
            PG8_WAIT_L(8); PG8_BAR; PG8_WAIT_L(0); PG8_MMA(0, 0, At, B0); PG8_BAR; PG8_SCHED;
            PG8_LDB(B1, 1, 1); PG8_STAGE(PG8_SB(1, 0), b3, voffB);
            PG8_BAR; PG8_WAIT_L(0); PG8_MMA(0, 1, At, B1); PG8_BAR;
            PG8_LDA(At, 1, 1); PG8_STAGE(PG8_SA(1, 0), a3, voffA);
            PG8_BAR; PG8_WAIT_L(0); PG8_MMA(1, 0, At, B0); PG8_BAR; PG8_SCHED;
            PG8_STAGE(PG8_SB(1, 1), b3 + hstep, voffB);
            PG8_WAIT_V(6); PG8_BAR; PG8_MMA(1, 1, At, B1); PG8_BAR;
            }
        }
        if constexpr (ALIGN_EPI) { if (wr == 0) PG8_BAR; }
        if constexpr (F8) asm volatile("s_nop 15\n\ts_nop 7" ::: "memory");
        if constexpr (!Epi::AFTER_DRAIN) { E(acc, cur, wr, wc, fr, fq); S.done(cur); }
        if (!has_next) break;
#pragma unroll
        for (int a = 0; a < 2; ++a)
#pragma unroll
            for (int b = 0; b < 2; ++b)
#pragma unroll
                for (int m = 0; m < 4; ++m)
#pragma unroll
                    for (int n = 0; n < 2; ++n) acc[a][b][m][n] = (f32x4){0.f, 0.f, 0.f, 0.f};
        cur = nxt; cA = nA; cB = nB; ++ui;
        if constexpr (ALIGN_EPI) { if (wr == 1) PG8_BAR; }
    }
    PG8_WAIT_V(0);
    if constexpr (!ALIGN_EPI) { if (wr == 0) PG8_BAR; }
    PG8_BAR;
    if constexpr (Epi::AFTER_DRAIN) { E.fused(acc, cur, wr, wc, fr, fq, lds, wid, lane); S.done(cur); }
#undef PG8_SA
#undef PG8_SB
#undef PG8_STAGE
#undef PG8_LDA
#undef PG8_LDB
#undef PG8_MMA
#undef PG8_WAIT_V
#undef PG8_WAIT_L
#undef PG8_BAR
#undef PG8_SCHED
}
}

constexpr int NB = 8, SEQ = 4096, DM = 1024, T = NB * SEQ, FF = 2816, DEPTH = 4;
constexpr float LN_EPS = 1e-5f, RMS_EPS = 1e-6f;
constexpr float DN_ALPHA = 1.681792830507429f;
constexpr int NTHREADS = 512, NWAVES = 8;
constexpr int LDS_BYTES = 147456;

#define LAS __attribute__((address_space(3)))
using pg8::bf16_t; using pg8::bf16x8; using pg8::f32x4; using pg8::u32x4; using pg8::Unit;
typedef float f32x2 __attribute__((ext_vector_type(2)));
typedef unsigned u32x2 __attribute__((ext_vector_type(2)));
typedef short s16x4 __attribute__((ext_vector_type(4)));

constexpr size_t MiB = 1u << 20;
constexpr size_t WS_SS = 1 * MiB;
constexpr size_t WS_TABM = 2 * MiB;
constexpr size_t WS_TABR = 110 * MiB + 256 * MiB;
constexpr size_t WS_WM = 12 * MiB;
constexpr size_t WS_WF = 28 * MiB;
constexpr size_t WS_XB = 46 * MiB;
constexpr size_t WS_A = 110 * MiB;
constexpr size_t WS_END = 512 * MiB;
constexpr size_t A_Y = WS_A + 292 * MiB;
constexpr size_t A_CQ = WS_A, A_CKV = WS_A + 32 * MiB, A_O = WS_A, A_KR = WS_A + 64 * MiB, A_Q = WS_A + 68 * MiB, A_KN = WS_A + 164 * MiB, A_V = WS_A + 228 * MiB;
constexpr size_t A_H = WS_A;
constexpr size_t A_RQ = WS_A, A_RK = WS_A + 64 * MiB, A_RV = WS_A + 128 * MiB, A_RY = WS_A + 256 * MiB, A_RG = WS_A, A_RA = WS_A + 128 * MiB;
constexpr size_t A_GQ = WS_A, A_GK = WS_A + 32 * MiB, A_GV = WS_A + 64 * MiB, A_GR = WS_A + 128 * MiB, A_GLR = WS_A + 192 * MiB, A_GY = WS_A + 196 * MiB, A_GY2 = WS_A + 260 * MiB, A_GQB = WS_A + 324 * MiB, A_GKB = WS_A + 356 * MiB, A_GET = WS_A + 388 * MiB, A_GA = WS_A;
constexpr size_t WM_MLA_DOWN = 0, WM_MLA_UQ = 2 * MiB, WM_MLA_UKV = 4 * MiB, WM_MLA_WO = 5 * MiB;
constexpr size_t WM_RET_IN = 0, WM_RET_WO = 12 * MiB;
constexpr size_t WM_GLA_IN = 0, WM_GLA_WO = 7 * MiB;
constexpr size_t WF_IN = 0, WF_OUT = 11 * MiB;

typedef __bf16 bf16x2_t __attribute__((ext_vector_type(2)));
__device__ __forceinline__ unsigned pk2(float lo, float hi) { const f32x2 v = {lo, hi}; const bf16x2_t b = __builtin_convertvector(v, bf16x2_t); return __builtin_bit_cast(unsigned, b); }
__device__ __forceinline__ float bf_lo(unsigned w) { return __uint_as_float(w << 16); }
__device__ __forceinline__ float bf_hi(unsigned w) { return __uint_as_float(w & 0xffff0000u); }
__device__ __forceinline__ float bf2f(bf16_t v) { return __uint_as_float((unsigned)v << 16); }
__device__ __forceinline__ bf16_t f2bf(float f) { return (bf16_t)(pk2(f, 0.f) & 0xffffu); }
__device__ __forceinline__ unsigned pk4_fp8(float a, float b, float c, float d) {
    a = __builtin_amdgcn_fmed3f(a, -440.f, 440.f); b = __builtin_amdgcn_fmed3f(b, -440.f, 440.f); c = __builtin_amdgcn_fmed3f(c, -440.f, 440.f); d = __builtin_amdgcn_fmed3f(d, -440.f, 440.f);
    int w = __builtin_amdgcn_cvt_pk_fp8_f32(a, b, 0, false); w = __builtin_amdgcn_cvt_pk_fp8_f32(c, d, w, true); return (unsigned)w; }
constexpr float C8_SCALE = 16.f, WU8_SCALE = 256.f;
constexpr float WD8_SCALE = 512.f, O8_SCALE = 128.f, WO8_SCALE = 1024.f;
constexpr float X8_SCALE = 16.f, W8IN_SCALE = 1024.f;
constexpr float H8_SCALE = 32.f, W8_SCALE = 2048.f;
__device__ __forceinline__ void st8(bf16_t* p, f32x4 a, f32x4 b) { u32x4 w; w.x = pk2(a[0], a[1]); w.y = pk2(a[2], a[3]); w.z = pk2(b[0], b[1]); w.w = pk2(b[2], b[3]); *(u32x4*)p = w; }
template <int CTRL> __device__ __forceinline__ float dppx(float v) { return __builtin_bit_cast(float, __builtin_amdgcn_update_dpp(0, __builtin_bit_cast(int, v), CTRL, 0xF, 0xF, true)); }
__device__ __forceinline__ float sum_x16(float v) { const auto a = __builtin_amdgcn_permlane16_swap(__float_as_uint(v), __float_as_uint(v), false, false); return __uint_as_float(a[0]) + __uint_as_float(a[1]); }
__device__ __forceinline__ float sum_x32(float v) { const auto a = __builtin_amdgcn_permlane32_swap(__float_as_uint(v), __float_as_uint(v), false, false); return __uint_as_float(a[0]) + __uint_as_float(a[1]); }
__device__ __forceinline__ float max_x16(float v) { const auto a = __builtin_amdgcn_permlane16_swap(__float_as_uint(v), __float_as_uint(v), false, false); return fmaxf(__uint_as_float(a[0]), __uint_as_float(a[1])); }
__device__ __forceinline__ float max_x32(float v) { const auto a = __builtin_amdgcn_permlane32_swap(__float_as_uint(v), __float_as_uint(v), false, false); return fmaxf(__uint_as_float(a[0]), __uint_as_float(a[1])); }
__device__ __forceinline__ float wave_sum(float v, int) {
    v += dppx<0xB1>(v);
    v += dppx<0x4E>(v);
    v += dppx<0x141>(v);
    v += dppx<0x140>(v);
    v = sum_x16(v); v = sum_x32(v);
    return v;
}
__device__ __forceinline__ float fexp2(float x) { return __builtin_amdgcn_exp2f(x); }
__device__ __forceinline__ float silu_f(float g) { return g / (1.f + __expf(-g)); }
__device__ __forceinline__ float logsigmoid_f(float x) { return fminf(x, 0.f) - __logf(1.f + __expf(-fabsf(x))); }
__device__ __forceinline__ f32x4 mfma16(bf16x8 a, bf16x8 b, f32x4 c) { return __builtin_amdgcn_mfma_f32_16x16x32_bf16(a, b, c, 0, 0, 0); }
__device__ __forceinline__ s16x4 tr_read(const LAS unsigned char* p) { return __builtin_bit_cast(s16x4, __builtin_amdgcn_ds_read_tr16_b64_v4i16((LAS s16x4*)p)); }
__device__ __forceinline__ bf16x8 tr_frag(const LAS unsigned char* tile, int stride, int krow0, int col0, int lane) {
    const int g = lane >> 4, a = (lane & 15) >> 2, p = lane & 3;
    const LAS unsigned char* q = tile + (krow0 + 4 * g + a) * stride + (col0 + 4 * p) * 2;
    const s16x4 lo = tr_read(q), hi = tr_read(q + 16 * stride);
    return (bf16x8){lo[0], lo[1], lo[2], lo[3], hi[0], hi[1], hi[2], hi[3]};
}
__device__ __forceinline__ bf16x8 pack_frag(f32x4 a, f32x4 b) { u32x4 w; w.x = pk2(a[0], a[1]); w.y = pk2(a[2], a[3]); w.z = pk2(b[0], b[1]); w.w = pk2(b[2], b[3]); return __builtin_bit_cast(bf16x8, w); }

__device__ __forceinline__ f32x2 rope_compute(int pos, int i, int nfreq) {
    const float inv = powf(10000.0f, -(float)i / (float)nfreq);
    const float ang = (float)pos * inv; float s, c; sincosf(ang, &s, &c); return (f32x2){c, s};
}
struct Rope8 { f32x4 v[4]; __device__ __forceinline__ float c(int i) const { return v[i >> 1][(i & 1) * 2]; } __device__ __forceinline__ float s(int i) const { return v[i >> 1][(i & 1) * 2 + 1]; } };
__device__ __forceinline__ Rope8 rope8(const f32x2* tab, int nfreq, int row, int i0) { Rope8 r; const f32x4* p = (const f32x4*)(tab + (size_t)row * nfreq + i0);
    r.v[0] = p[0]; r.v[1] = p[1]; r.v[2] = p[2]; r.v[3] = p[3]; return r; }

#define EPI_ROW(u, ai, wr, m, fr) ((u).pm * 256 + (ai) * 128 + (wr) * 64 + (m) * 16 + (fr))
struct Seg { bf16_t* base; int ldc; int pn0; float scale; };
struct EpiStore {
    static constexpr bool PERM = true, AFTER_DRAIN = false;
    Seg s0, s1, s2, s3; int nseg;
    const float* ss; int ss_col; float ss_invk;
    float* lr; int lr_pn;
    __device__ __forceinline__ void operator()(const f32x4 (&acc)[2][2][4][2], const Unit& u, int wr, int wc, int fr, int fq) const {
        asm volatile("" : "+v"(fr), "+v"(fq));
        if (lr && u.pn == lr_pn) {
            if (wc == 0) {
#pragma unroll
                for (int ai = 0; ai < 2; ++ai)
#pragma unroll
                    for (int m = 0; m < 4; ++m) { const int row = EPI_ROW(u, ai, wr, m, fr); float* p = lr + (size_t)row * 32 + 8 * fq; *(f32x4*)p = acc[ai][0][m][0]; *(f32x4*)(p + 4) = acc[ai][0][m][1]; }
            }
            return;
        }
        Seg sg = s0; if (nseg > 1 && u.pn >= s1.pn0) sg = s1; if (nseg > 2 && u.pn >= s2.pn0) sg = s2; if (nseg > 3 && u.pn >= s3.pn0) sg = s3;
        const int colt = (u.pn - sg.pn0) * 256 + wc * 32 + 8 * fq;
#pragma unroll
        for (int ai = 0; ai < 2; ++ai)
#pragma unroll
            for (int m = 0; m < 4; ++m) {
                const int row = EPI_ROW(u, ai, wr, m, fr); float sc = sg.scale;
                if (ss) sc *= rsqrtf(ss[(size_t)row * 2 + ss_col] * ss_invk + RMS_EPS);
                bf16_t* rp = sg.base + (size_t)row * sg.ldc + colt;
#pragma unroll
                for (int bj = 0; bj < 2; ++bj) st8(rp + bj * 128, acc[ai][bj][m][0] * sc, acc[ai][bj][m][1] * sc);
            }
    }
};
struct EpiDown {
    static constexpr bool PERM = true, AFTER_DRAIN = false;
    bf16_t *CQ, *CKV, *KR; float* SS; const f32x2* tab; float inscale;
    __device__ __forceinline__ void operator()(const f32x4 (&acc)[2][2][4][2], const Unit& u, int wr, int wc, int fr, int fq) const {
        asm volatile("" : "+v"(fr), "+v"(fq));
        if (u.pn < 3) {
            bf16_t* base = u.pn < 2 ? CQ : CKV; const int ldc = u.pn < 2 ? 512 : 256, colt = (u.pn < 2 ? u.pn * 256 : 0) + wc * 32 + 8 * fq, sscol = u.pn < 2 ? 0 : 1;
#pragma unroll
            for (int ai = 0; ai < 2; ++ai)
#pragma unroll
                for (int m = 0; m < 4; ++m) {
                    const int row = EPI_ROW(u, ai, wr, m, fr); unsigned char* rp = (unsigned char*)base + (size_t)row * ldc + colt; float sq = 0.f;
#pragma unroll
                    for (int bj = 0; bj < 2; ++bj) { const f32x4 a = acc[ai][bj][m][0] * inscale, b = acc[ai][bj][m][1] * inscale;
                        { u32x2 w8; w8.x = pk4_fp8(a[0] * C8_SCALE, a[1] * C8_SCALE, a[2] * C8_SCALE, a[3] * C8_SCALE); w8.y = pk4_fp8(b[0] * C8_SCALE, b[1] * C8_SCALE, b[2] * C8_SCALE, b[3] * C8_SCALE); *(u32x2*)(rp + bj * 128) = w8; }
                        sq += (a[0] * a[0] + a[1] * a[1]) + (a[2] * a[2] + a[3] * a[3]) + (b[0] * b[0] + b[1] * b[1]) + (b[2] * b[2] + b[3] * b[3]); }
                    sq = sum_x16(sq); sq = sum_x32(sq);
                    if (fq == 0) atomicAdd(SS + (size_t)row * 2 + sscol, sq); asm volatile("" ::: "memory");
                }
        } else if (wc == 0) {
            Rope8 Rn = rope8(tab, 32, EPI_ROW(u, 0, wr, 0, fr), 8 * fq);
#pragma unroll
            for (int ai = 0; ai < 2; ++ai)
#pragma unroll
                for (int m = 0; m < 4; ++m) {
                    const int row = EPI_ROW(u, ai, wr, m, fr); const Rope8 R = Rn; f32x4 o1[2], o2[2];
                    if (ai * 4 + m < 7) Rn = rope8(tab, 32, EPI_ROW(u, (ai * 4 + m + 1) >> 2, wr, (ai * 4 + m + 1) & 3, fr), 8 * fq);
#pragma unroll
                    for (int n = 0; n < 2; ++n)
#pragma unroll
                        for (int i = 0; i < 4; ++i) { const float cc = R.c(4 * n + i), sn = R.s(4 * n + i); const float x1 = acc[ai][0][m][n][i] * inscale, x2 = acc[ai][1][m][n][i] * inscale;
                            o1[n][i] = x1 * cc - x2 * sn; o2[n][i] = x1 * sn + x2 * cc; }
                    bf16_t* rp = KR + (size_t)row * 64 + 8 * fq; st8(rp, o1[0], o1[1]); st8(rp + 32, o2[0], o2[1]); asm volatile("" ::: "memory");
                }
        }
    }
};
struct EpiUq {
    static constexpr bool PERM = true, AFTER_DRAIN = false;
    bf16_t* Q; const float* SS; const f32x2* tab; float qscale;
    __device__ __forceinline__ void operator()(const f32x4 (&acc)[2][2][4][2], const Unit& u, int wr, int wc, int fr, int fq) const {
        asm volatile("" : "+v"(fr), "+v"(fq));
        Rope8 Rn; if (u.pn >= 4) Rn = rope8(tab, 32, EPI_ROW(u, 0, wr, 0, fr), 8 * fq); else { Rn.v[0] = Rn.v[1] = Rn.v[2] = Rn.v[3] = (f32x4){0.f, 0.f, 0.f, 0.f}; }
#pragma unroll
        for (int ai = 0; ai < 2; ++ai)
#pragma unroll
            for (int m = 0; m < 4; ++m) {
                const int row = EPI_ROW(u, ai, wr, m, fr); const float rs = rsqrtf(SS[(size_t)row * 2] * (1.f / 512.f) + RMS_EPS) * qscale;
                bf16_t* rp = Q + (size_t)row * 1536;
                if (u.pn < 4) {
#pragma unroll
                    for (int bj = 0; bj < 2; ++bj) st8(rp + (2 * u.pn + bj) * 192 + wc * 32 + 8 * fq, acc[ai][bj][m][0] * rs, acc[ai][bj][m][1] * rs);
                } else {
                    const int h = 4 * (u.pn - 4) + wc; const Rope8 R = Rn; f32x4 o1[2], o2[2];
                    if (ai * 4 + m < 7) Rn = rope8(tab, 32, EPI_ROW(u, (ai * 4 + m + 1) >> 2, wr, (ai * 4 + m + 1) & 3, fr), 8 * fq);
#pragma unroll
                    for (int n = 0; n < 2; ++n)
#pragma unroll
                        for (int i = 0; i < 4; ++i) { const float cc = R.c(4 * n + i), sn = R.s(4 * n + i); const float x1 = acc[ai][0][m][n][i] * rs, x2 = acc[ai][1][m][n][i] * rs;
                            o1[n][i] = x1 * cc - x2 * sn; o2[n][i] = x1 * sn + x2 * cc; }
                    st8(rp + h * 192 + 128 + 8 * fq, o1[0], o1[1]); st8(rp + h * 192 + 160 + 8 * fq, o2[0], o2[1]); asm volatile("" ::: "memory");
                }
            }
    }
};
struct EpiRet {
    static constexpr bool PERM = true, AFTER_DRAIN = false;
    bf16_t *Q, *K, *V; const f32x2* tab;
    __device__ __forceinline__ void operator()(const f32x4 (&acc)[2][2][4][2], const Unit& u, int wr, int wc, int fr, int fq) const {
        asm volatile("" : "+v"(fr), "+v"(fq));
        if (u.pn < 8) {
            bf16_t* base = u.pn < 4 ? Q : K; const int hh = u.pn & 3; const float sc = u.pn < 4 ? 1.f : 0.0625f;
            Rope8 Rn = rope8(tab, 128, EPI_ROW(u, 0, wr, 0, fr), wc * 32 + 8 * fq);
#pragma unroll
            for (int ai = 0; ai < 2; ++ai)
#pragma unroll
                for (int m = 0; m < 4; ++m) {
                    const int row = EPI_ROW(u, ai, wr, m, fr); const Rope8 R = Rn; f32x4 o1[2], o2[2];
                    if (ai * 4 + m < 7) Rn = rope8(tab, 128, EPI_ROW(u, (ai * 4 + m + 1) >> 2, wr, (ai * 4 + m + 1) & 3, fr), wc * 32 + 8 * fq);
#pragma unroll
                    for (int n = 0; n < 2; ++n)
#pragma unroll
                        for (int i = 0; i < 4; ++i) { const float cc = R.c(4 * n + i), sn = R.s(4 * n + i); const float x1 = acc[ai][0][m][n][i] * sc, x2 = acc[ai][1][m][n][i] * sc;
                            o1[n][i] = x1 * cc - x2 * sn; o2[n][i] = x1 * sn + x2 * cc; }
                    bf16_t* rp = base + (size_t)row * 1024 + hh * 256 + wc * 32 + 8 * fq; st8(rp, o1[0], o1[1]); st8(rp + 128, o2[0], o2[1]); asm volatile("" ::: "memory");
                }
        } else {
#pragma unroll
            for (int ai = 0; ai < 2; ++ai)
#pragma unroll
                for (int m = 0; m < 4; ++m) {
                    const int row = EPI_ROW(u, ai, wr, m, fr); bf16_t* rp = V + (size_t)row * 2048 + (u.pn - 8) * 256 + wc * 32 + 8 * fq;
#pragma unroll
                    for (int bj = 0; bj < 2; ++bj) st8(rp + bj * 128, acc[ai][bj][m][0], acc[ai][bj][m][1]);
                }
        }
    }
};
struct EpiSwiglu {
    static constexpr bool PERM = true, AFTER_DRAIN = false;
    bf16_t* H; float inscale;
    __device__ __forceinline__ void operator()(const f32x4 (&acc)[2][2][4][2], const Unit& u, int wr, int wc, int fr, int fq) const {
        asm volatile("" : "+v"(fr), "+v"(fq));
#pragma unroll
        for (int ai = 0; ai < 2; ++ai)
#pragma unroll
            for (int m = 0; m < 4; ++m) {
                const int row = EPI_ROW(u, ai, wr, m, fr); f32x4 o[2];
#pragma unroll
                for (int n = 0; n < 2; ++n)
#pragma unroll
                    for (int i = 0; i < 4; ++i) o[n][i] = silu_f(acc[ai][0][m][n][i] * inscale) * (acc[ai][1][m][n][i] * inscale) * H8_SCALE;
                u32x2 w8; w8.x = pk4_fp8(o[0][0], o[0][1], o[0][2], o[0][3]); w8.y = pk4_fp8(o[1][0], o[1][1], o[1][2], o[1][3]);
                *(u32x2*)((unsigned char*)H + (size_t)row * FF + u.pn * 128 + wc * 32 + 8 * fq) = w8;
            }
    }
};

struct Cvt { LAS float* scr; int gw, ngw, lane, off; };
__device__ __forceinline__ void cvt_run(Cvt& C, const float* W, int pitch, int K, int src0, bf16_t* WT, int dst0, int nrows, const float* gain, bool a1 = false, bool f8 = false, float f8s = 1.f) {
    const int nblk = nrows / 32, nitems = (K / 64) * nblk, lane = C.lane;
    int first = C.gw - (C.off % C.ngw); if (first < 0) first += C.ngw;
    for (int item = first; item < nitems; item += C.ngw) {
        const int kb = item / nblk, nb = item % nblk, k0 = 64 * kb, n0 = 32 * nb;
        if (a1) {
#pragma unroll 8
            for (int i = 0; i < 32; ++i) { const int kk = 2 * i + (lane >> 5), k = k0 + kk, c = lane & 31;
                C.scr[kk * 33 + c] = W[(size_t)(c >> 4) * K * 16 + (size_t)k * 16 + (c & 15)]; }
        } else {
#pragma unroll
            for (int i = 0; i < 8; ++i) { const int kk = 8 * i + (lane >> 3), k = k0 + kk, c = (lane & 7) * 4;
                f32x4 v = *(const f32x4*)(W + (size_t)k * pitch + src0 + n0 + c);
                if (gain) v = v * gain[k];
                LAS float* sp = C.scr + kk * 33 + c; sp[0] = v[0]; sp[1] = v[1]; sp[2] = v[2]; sp[3] = v[3]; }
        }
        asm volatile("s_waitcnt lgkmcnt(0)" ::: "memory");
        const int c8 = lane & 7;
#pragma unroll
        for (int j = 0; j < 4; ++j) { const int n = (lane >> 3) + 8 * j; const LAS float* s = C.scr + (8 * c8) * 33 + n;
            if (f8) { u32x2 o8; o8.x = pk4_fp8(s[0 * 33] * f8s, s[1 * 33] * f8s, s[2 * 33] * f8s, s[3 * 33] * f8s); o8.y = pk4_fp8(s[4 * 33] * f8s, s[5 * 33] * f8s, s[6 * 33] * f8s, s[7 * 33] * f8s);
                *(u32x2*)((unsigned char*)WT + (size_t)(dst0 + n0 + n) * K + k0 + 8 * c8) = o8; }
            else { u32x4 o; o.x = pk2(s[0 * 33], s[1 * 33]); o.y = pk2(s[2 * 33], s[3 * 33]); o.z = pk2(s[4 * 33], s[5 * 33]); o.w = pk2(s[6 * 33], s[7 * 33]);
                *(u32x4*)(WT + (size_t)(dst0 + n0 + n) * K + k0 + 8 * c8) = o; } }
        asm volatile("s_waitcnt lgkmcnt(0)" ::: "memory");
    }
    C.off += nitems;
}
__device__ __forceinline__ void cvt_zero(Cvt& C, bf16_t* WT, int K, int dst0, int nrows) {
    const int nchunks = nrows * K / 8;
    for (int c = C.gw * 64 + C.lane; c < nchunks; c += C.ngw * 64) *(u32x4*)(WT + (size_t)dst0 * K + (size_t)c * 8) = (u32x4){0u, 0u, 0u, 0u};
}
struct Inputs { const float* x; const int* pos; const float *ln_g, *ln_b, *ffn_in, *ffn_out, *mla_down, *mla_qn, *mla_uq, *mla_kvn, *mla_ukv, *mla_wo,
                *ret_in, *ret_decay, *ret_gnw, *ret_gnb, *ret_wo, *gla_in, *gla_a1, *gla_a2, *gla_ba, *gla_norm, *gla_wo; };
__device__ __forceinline__ int phase_tid(int wv) { int t; asm volatile("v_mbcnt_lo_u32_b32 %0, -1, 0\n\tv_mbcnt_hi_u32_b32 %0, -1, %0" : "=v"(t)); return t + wv * 64; }
struct Args { Inputs in; float* out; unsigned char* ws; int ph_lo, ph_hi; };
typedef const __attribute__((address_space(4))) Args* KArgs;
#if defined(__HIP_DEVICE_COMPILE__)
__device__ __forceinline__ void convert_layer(Cvt& C, KArgs ap, unsigned char* ws, int L) {
    const int kind = L % 3, j = L / 3;
    bf16_t* wm = (bf16_t*)(ws + WS_WM);
    if (kind == 0) {
        const float* wd = ap->in.mla_down + (size_t)j * 1024 * 832; bf16_t* d = (bf16_t*)(ws + WS_WM + WM_MLA_DOWN);
        cvt_run(C, wd, 832, 1024, 0, d, 0, 768, nullptr, false, true, WD8_SCALE); cvt_run(C, wd, 832, 1024, 768, d, 768, 32, nullptr, false, true, WD8_SCALE); cvt_run(C, wd, 832, 1024, 800, d, 896, 32, nullptr, false, true, WD8_SCALE);
        cvt_zero(C, d, 512, 800, 96); cvt_zero(C, d, 512, 928, 96);
        const float* wq = ap->in.mla_uq + (size_t)j * 512 * 1536; const float* gq = ap->in.mla_qn + j * 512; bf16_t* q = (bf16_t*)(ws + WS_WM + WM_MLA_UQ);
        for (int h = 0; h < 8; ++h) cvt_run(C, wq, 1536, 512, h * 192, q, h * 128, 128, gq, false, true, WU8_SCALE);
        for (int t = 0; t < 2; ++t) for (int bj = 0; bj < 2; ++bj) for (int hh = 0; hh < 4; ++hh) cvt_run(C, wq, 1536, 512, (4 * t + hh) * 192 + 128 + bj * 32, q, 1024 + t * 256 + bj * 128 + hh * 32, 32, gq, false, true, WU8_SCALE);
        const float* wk = ap->in.mla_ukv + (size_t)j * 256 * 2048; const float* gk = ap->in.mla_kvn + j * 256; bf16_t* kv = (bf16_t*)(ws + WS_WM + WM_MLA_UKV);
        for (int h = 0; h < 8; ++h) { cvt_run(C, wk, 2048, 256, h * 256, kv, h * 128, 128, gk, false, true, WU8_SCALE); cvt_run(C, wk, 2048, 256, h * 256 + 128, kv, 1024 + h * 128, 128, gk, false, true, WU8_SCALE); }
        cvt_run(C, ap->in.mla_wo + (size_t)j * 1024 * 1024, 1024, 1024, 0, (bf16_t*)(ws + WS_WM + WM_MLA_WO), 0, 1024, nullptr, false, true, WO8_SCALE);
    } else if (kind == 1) {
        cvt_run(C, ap->in.ret_in + (size_t)j * 1024 * 6144, 6144, 1024, 0, (bf16_t*)(ws + WS_WM + WM_RET_IN), 0, 6144, nullptr);
        cvt_run(C, ap->in.ret_wo + (size_t)j * 2048 * 1024, 1024, 2048, 0, (bf16_t*)(ws + WS_WM + WM_RET_WO), 0, 1024, nullptr);
    } else {
        bf16_t* gi = (bf16_t*)(ws + WS_WM + WM_GLA_IN);
        cvt_run(C, ap->in.gla_in + (size_t)j * 1024 * 3072, 3072, 1024, 0, gi, 0, 3072, nullptr);
        cvt_run(C, ap->in.gla_a1 + (size_t)j * 2 * 1024 * 16, 16, 1024, 0, gi, 3072, 32, nullptr, true);
        cvt_zero(C, gi, 1024, 3104, 224);
        cvt_run(C, ap->in.gla_wo + (size_t)j * 1024 * 1024, 1024, 1024, 0, (bf16_t*)(ws + WS_WM + WM_GLA_WO), 0, 1024, nullptr);
    }
    (void)wm;
    const float* fi = ap->in.ffn_in + (size_t)L * 1024 * 5632; bf16_t* f1 = (bf16_t*)(ws + WS_WF + WF_IN);
    for (int t = 0; t < 22; ++t) { cvt_run(C, fi, 5632, 1024, 128 * t, f1, 256 * t, 128, nullptr, false, true, W8IN_SCALE); cvt_run(C, fi, 5632, 1024, 2816 + 128 * t, f1, 256 * t + 128, 128, nullptr, false, true, W8IN_SCALE); }
    cvt_run(C, ap->in.ffn_out + (size_t)L * 2816 * 1024, 1024, 2816, 0, (bf16_t*)(ws + WS_WF + WF_OUT), 0, 1024, nullptr, false, true, W8_SCALE);
}

#endif
__device__ __forceinline__ void ln_phase(const float* xin, const bf16_t* y, const float* g, const float* b, float* xout, bf16_t* xb, int gw, int ngw, int lane, const float ymul = 1.f, const bool f8out = false, const bool noxb = false) {
    f32x4 gv[4], bv[4];
#pragma unroll
    for (int j = 0; j < 4; ++j) { gv[j] = *(const f32x4*)(g + 4 * lane + 256 * j); bv[j] = *(const f32x4*)(b + 4 * lane + 256 * j); }
    constexpr int R = 4;
    for (int row = gw; row < T; row += R * ngw) {
        f32x4 xv[R][4]; u32x2 yv[R][4];
#pragma unroll
        for (int h = 0; h < R; ++h) { const int rr = (row + h * ngw < T) ? row + h * ngw : row;
#pragma unroll
            for (int j = 0; j < 4; ++j) { xv[h][j] = *(const f32x4*)(xin + (size_t)rr * DM + 4 * lane + 256 * j); yv[h][j] = *(const u32x2*)(y + (size_t)rr * DM + 4 * lane + 256 * j); } }
#pragma unroll
        for (int h = 0; h < R; ++h) {
            const int rr = row + h * ngw;
            if (rr < T) {
                f32x4 v[4]; float s = 0.f;
#pragma unroll
                for (int j = 0; j < 4; ++j) { const f32x4 xq = xv[h][j]; const u32x2 yw = yv[h][j];
                    v[j] = (f32x4){DN_ALPHA * xq[0] + ymul * bf_lo(yw.x), DN_ALPHA * xq[1] + ymul * bf_hi(yw.x), DN_ALPHA * xq[2] + ymul * bf_lo(yw.y), DN_ALPHA * xq[3] + ymul * bf_hi(yw.y)};
                    s += (v[j][0] + v[j][1]) + (v[j][2] + v[j][3]); }
                const float mean = wave_sum(s, lane) * (1.f / DM); float q = 0.f;
#pragma unroll
                for (int j = 0; j < 4; ++j) { v[j] = v[j] - mean; q += (v[j][0] * v[j][0] + v[j][1] * v[j][1]) + (v[j][2] * v[j][2] + v[j][3] * v[j][3]); }
                const float rstd = rsqrtf(wave_sum(q, lane) * (1.f / DM) + LN_EPS);
#pragma unroll
                for (int j = 0; j < 4; ++j) { const f32x4 o = v[j] * rstd * gv[j] + bv[j];
                    *(f32x4*)(xout + (size_t)rr * DM + 4 * lane + 256 * j) = o;
                    if (noxb) { }
                    else if (f8out) *(unsigned*)((unsigned char*)xb + (size_t)rr * DM + 4 * lane + 256 * j) = pk4_fp8(o[0] * X8_SCALE, o[1] * X8_SCALE, o[2] * X8_SCALE, o[3] * X8_SCALE);
                    else { u32x2 w; w.x = pk2(o[0], o[1]); w.y = pk2(o[2], o[3]); *(u32x2*)(xb + (size_t)rr * DM + 4 * lane + 256 * j) = w; } }
            }
        }
    }
}
__device__ __forceinline__ void ret_gate_phase(const bf16_t* y, const bf16_t* g, const float* gnw, const float* gnb, bf16_t* a, int gw, int ngw, int lane) {
    for (int row = gw; row < T; row += ngw) {
        u32x4 yq[4], gq4[4];
#pragma unroll
        for (int h = 0; h < 4; ++h) { const size_t off = (size_t)row * 2048 + 512 * h + 8 * lane; yq[h] = *(const u32x4*)(y + off); gq4[h] = *(const u32x4*)(g + off); }
#pragma unroll
        for (int h = 0; h < 4; ++h) {
            const size_t off = (size_t)row * 2048 + 512 * h + 8 * lane;
            const u32x4 yw = yq[h], gq = gq4[h];
            float v[8] = {bf_lo(yw.x), bf_hi(yw.x), bf_lo(yw.y), bf_hi(yw.y), bf_lo(yw.z), bf_hi(yw.z), bf_lo(yw.w), bf_hi(yw.w)};
            const float gg[8] = {bf_lo(gq.x), bf_hi(gq.x), bf_lo(gq.y), bf_hi(gq.y), bf_lo(gq.z), bf_hi(gq.z), bf_lo(gq.w), bf_hi(gq.w)};
            float s = 0.f;
#pragma unroll
            for (int i = 0; i < 8; ++i) s += v[i];
            const float mean = wave_sum(s, lane) * (1.f / 512.f); float q = 0.f;
#pragma unroll
            for (int i = 0; i < 8; ++i) { v[i] -= mean; q += v[i] * v[i]; }
            const float rstd = rsqrtf(wave_sum(q, lane) * (1.f / 512.f) + LN_EPS);
            const f32x4 w0 = *(const f32x4*)(gnw + 512 * h + 8 * lane), w1 = *(const f32x4*)(gnw + 512 * h + 8 * lane + 4), b0 = *(const f32x4*)(gnb + 512 * h + 8 * lane), b1 = *(const f32x4*)(gnb + 512 * h + 8 * lane + 4);
            f32x4 o0, o1;
#pragma unroll
            for (int i = 0; i < 4; ++i) { o0[i] = silu_f(gg[i]) * (v[i] * rstd * w0[i] + b0[i]); o1[i] = silu_f(gg[4 + i]) * (v[4 + i] * rstd * w1[i] + b1[i]); }
            st8(a + off, o0, o1);
        }
    }
}
__device__ __forceinline__ void gla_gate_phase(const bf16_t* y, const bf16_t* y2, const bf16_t* r, const float* ng, bf16_t* a, int gw, int ngw, int lane) {
    const f32x4 nv = *(const f32x4*)(ng + 4 * lane);
    for (int row = gw; row < T; row += ngw) {
#pragma unroll
        for (int h = 0; h < 4; ++h) {
            const size_t off = (size_t)row * 1024 + 256 * h + 4 * lane;
            const u32x2 yw = *(const u32x2*)(y + off), yw2 = *(const u32x2*)(y2 + off), rw = *(const u32x2*)(r + off);
            const float v[4] = {bf_lo(yw.x) + bf_lo(yw2.x), bf_hi(yw.x) + bf_hi(yw2.x), bf_lo(yw.y) + bf_lo(yw2.y), bf_hi(yw.y) + bf_hi(yw2.y)}; const float rr[4] = {bf_lo(rw.x), bf_hi(rw.x), bf_lo(rw.y), bf_hi(rw.y)};
            const float q = (v[0] * v[0] + v[1] * v[1]) + (v[2] * v[2] + v[3] * v[3]);
            const float rs = rsqrtf(wave_sum(q, lane) * (1.f / 256.f) + RMS_EPS);
            u32x2 w; w.x = pk2(silu_f(rr[0]) * v[0] * rs * nv[0], silu_f(rr[1]) * v[1] * rs * nv[1]); w.y = pk2(silu_f(rr[2]) * v[2] * rs * nv[2], silu_f(rr[3]) * v[3] * rs * nv[3]);
            *(u32x2*)(a + off) = w;
        }
    }
}

constexpr int AT_KS = 400, AT_VS = 288, AT_KB = 64 * AT_KS, AT_BUF = AT_KB + 64 * AT_VS;
static_assert(3 * AT_BUF <= LDS_BYTES - 64, "attention LDS");
__device__ __forceinline__ void attn_phase(LAS unsigned char* lds, const bf16_t* Q, const bf16_t* KN, const bf16_t* KR, const bf16_t* V, bf16_t* O, int bid, int G, const int tid) {
    const int lane_ = tid & 63, wid = __builtin_amdgcn_readfirstlane(tid >> 6), r_ = lane_ & 15, g_ = lane_ >> 4;
    const int vcu = (G % 8 == 0) ? (bid % 8) * (G / 8) + bid / 8 : bid;
    const bool late = wid >= 4;
    constexpr int NT = SEQ / 64;
    for (int it = vcu; it < NB * 8 * 16; it += G) {
        const int bh = it >> 4, qb = it & 15, b = bh >> 3, h = bh & 7; const size_t rowbase = (size_t)b * SEQ;
        bf16x8 qf[2][6];
        { const int r = r_, g = g_; const bf16_t* qp = Q + (rowbase + qb * 256 + wid * 32 + r) * 1536 + h * 192 + 8 * g;
#pragma unroll
          for (int qt = 0; qt < 2; ++qt)
#pragma unroll
              for (int s = 0; s < 6; ++s) qf[qt][s] = *(const bf16x8*)(qp + (size_t)qt * 16 * 1536 + 32 * s); }
        f32x4 o[8][2];
#pragma unroll
        for (int dt = 0; dt < 8; ++dt) { o[dt][0] = (f32x4){0.f, 0.f, 0.f, 0.f}; o[dt][1] = (f32x4){0.f, 0.f, 0.f, 0.f}; }
        float mrow[2] = {0.f, 0.f}, lrow[2] = {0.f, 0.f};
        u32x4 rk[2], rr, rv[2];
        const int c0_ = tid, c1_ = tid + 512;
        const bf16_t* gk = KN + rowbase * 1024 + h * 128; const bf16_t* gr = KR + rowbase * 64; const bf16_t* gv = V + rowbase * 1024 + h * 128;
#define AT_LOAD(t) do { const size_t k0_ = (size_t)(t) * 64; \
            rk[0] = *(const u32x4*)(gk + (k0_ + (c0 >> 4)) * 1024 + (c0 & 15) * 8); rk[1] = *(const u32x4*)(gk + (k0_ + (c1 >> 4)) * 1024 + (c1 & 15) * 8); \
            rr = *(const u32x4*)(gr + (k0_ + (c0 >> 3)) * 64 + (c0 & 7) * 8); \
            rv[0] = *(const u32x4*)(gv + (k0_ + (c0 >> 4)) * 1024 + (c0 & 15) * 8); rv[1] = *(const u32x4*)(gv + (k0_ + (c1 >> 4)) * 1024 + (c1 & 15) * 8); } while (0)
#define AT_STORE(buf) do { LAS unsigned char* kb_ = lds + (buf) * AT_BUF; LAS unsigned char* vb_ = kb_ + AT_KB; \
            *(LAS u32x4*)(kb_ + (c0 >> 4) * AT_KS + (c0 & 15) * 16) = rk[0]; *(LAS u32x4*)(kb_ + (c1 >> 4) * AT_KS + (c1 & 15) * 16) = rk[1]; \
            *(LAS u32x4*)(kb_ + (c0 >> 3) * AT_KS + 256 + (c0 & 7) * 16) = rr; \
            *(LAS u32x4*)(vb_ + (c0 >> 4) * AT_VS + (c0 & 15) * 16) = rv[0]; *(LAS u32x4*)(vb_ + (c1 >> 4) * AT_VS + (c1 & 15) * 16) = rv[1]; } while (0)
#define AT_QK(kbp) do { __builtin_amdgcn_s_setprio(1); \
            { const float n0_ = -mrow[0], n1_ = -mrow[1];     \
              _Pragma("unroll") for (int kt = 0; kt < 4; ++kt) { s[kt][0] = (f32x4){n0_, n0_, n0_, n0_}; s[kt][1] = (f32x4){n1_, n1_, n1_, n1_}; } } \
            _Pragma("unroll") for (int ks = 0; ks < 6; ++ks) { \
                _Pragma("unroll") for (int kt = 0; kt < 4; ++kt) { const bf16x8 kf = *(const LAS bf16x8*)((kbp) + (16 * kt + r) * AT_KS + (32 * ks + 8 * g) * 2); \
                    s[kt][0] = mfma16(kf, qf[0][ks], s[kt][0]); s[kt][1] = mfma16(kf, qf[1][ks], s[kt][1]); } \
                if (ks & 1) asm volatile("" ::: "memory"); } \
            __builtin_amdgcn_s_setprio(0); } while (0)
#define AT_SM1(qt) do { \
            float mx = fmaxf(fmaxf(s[0][qt][0], s[0][qt][1]), fmaxf(s[0][qt][2], s[0][qt][3])); \
            _Pragma("unroll") for (int kt = 1; kt < 4; ++kt) mx = fmaxf(mx, fmaxf(fmaxf(s[kt][qt][0], s[kt][qt][1]), fmaxf(s[kt][qt][2], s[kt][qt][3]))); \
            mx = max_x16(mx); mx = max_x32(mx); \
            if (t == 0 || __any(mx > 8.f)) {     \
                const float dl = (t == 0) ? mx : fmaxf(mx, 0.f); mrow[qt] += dl; \
                if (t != 0) { const float alpha = fexp2(-dl); lrow[qt] *= alpha; \
                    _Pragma("unroll") for (int dt = 0; dt < 8; ++dt) o[dt][qt] = o[dt][qt] * alpha; } \
                _Pragma("unroll") for (int kt = 0; kt < 4; ++kt) s[kt][qt] = s[kt][qt] - dl; \
            } \
            float rs = 0.f; \
            _Pragma("unroll") for (int kt = 0; kt < 4; ++kt) \
                _Pragma("unroll") for (int j = 0; j < 4; ++j) { const float p = fexp2(s[kt][qt][j]); s[kt][qt][j] = p; rs += p; } \
            lrow[qt] += rs; \
            pf[qt][0] = pack_frag(s[0][qt], s[1][qt]); pf[qt][1] = pack_frag(s[2][qt], s[3][qt]); } while (0)
#define AT_PV(vbp) do { __builtin_amdgcn_s_setprio(1); \
            _Pragma("unroll") for (int k2 = 0; k2 < 2; ++k2) \
                _Pragma("unroll") for (int dt = 0; dt < 8; ++dt) { const bf16x8 vf = tr_frag((vbp), AT_VS, 32 * k2, 16 * dt, lane); \
                    o[dt][0] = mfma16(vf, pf[0][k2], o[dt][0]); o[dt][1] = mfma16(vf, pf[1][k2], o[dt][1]); } \
            __builtin_amdgcn_s_setprio(0); } while (0)
        bf16x8 pf[2][2];
        pf[0][0] = pf[0][1] = pf[1][0] = pf[1][1] = (bf16x8){0, 0, 0, 0, 0, 0, 0, 0};
        { int c0 = c0_, c1 = c1_; asm volatile("" : "+v"(c0), "+v"(c1));
          AT_LOAD(0);
          __syncthreads();
          AT_STORE(0);
          __syncthreads(); }
        if (!late) {
            int b_cur = 0;
            for (int t = 0; t < NT; ++t) {
                int lane = lane_, r = r_, g = g_, c0 = c0_, c1 = c1_;
                asm volatile("" : "+v"(lane), "+v"(r), "+v"(g), "+v"(c0), "+v"(c1));
                const int b_nxt = (b_cur == 2) ? 0 : b_cur + 1;
                if (t + 1 < NT) AT_LOAD(t + 1);
                const LAS unsigned char* kb = lds + b_cur * AT_BUF; const LAS unsigned char* vb = kb + AT_KB;
                f32x4 s[4][2];
                AT_QK(kb);
                AT_SM1(0); AT_SM1(1);
                if (t + 1 < NT) AT_STORE(b_nxt);
                AT_PV(vb);
                __syncthreads();
                b_cur = b_nxt;
            }
        } else {
            int b_cur = 0, b_prev = 2;
            for (int t = 0; t < NT; ++t) {
                int lane = lane_, r = r_, g = g_, c0 = c0_, c1 = c1_;
                asm volatile("" : "+v"(lane), "+v"(r), "+v"(g), "+v"(c0), "+v"(c1));
                const int b_nxt = (b_cur == 2) ? 0 : b_cur + 1;
                const LAS unsigned char* kb = lds + b_cur * AT_BUF; const LAS unsigned char* vbp = lds + b_prev * AT_BUF + AT_KB;
                if (t > 0) AT_PV(vbp);
                asm volatile("" ::: "memory");
                if (t + 1 < NT) AT_LOAD(t + 1);
                f32x4 s[4][2];
                AT_QK(kb);
                AT_SM1(0); AT_SM1(1);
                if (t + 1 < NT) AT_STORE(b_nxt);
                __syncthreads();
                b_prev = b_cur; b_cur = b_nxt;
            }
            { int lane = lane_; asm volatile("" : "+v"(lane)); const LAS unsigned char* vbp = lds + b_prev * AT_BUF + AT_KB; AT_PV(vbp); }
        }
#undef AT_LOAD
#undef AT_STORE
#undef AT_QK
#undef AT_SM1
#undef AT_PV
        int re = tid & 15, ge = (tid & 63) >> 4; asm volatile("" : "+v"(re), "+v"(ge));
#pragma unroll
        for (int qt = 0; qt < 2; ++qt) {
            float l = lrow[qt]; l = sum_x16(l); l = sum_x32(l); const float inv = 1.f / l;
            unsigned char* op = (unsigned char*)O + (rowbase + qb * 256 + wid * 32 + 16 * qt + re) * 1024 + h * 128 + 4 * ge;
            const float inv8 = inv * O8_SCALE;
#pragma unroll
            for (int dt = 0; dt < 8; ++dt) *(unsigned*)(op + 16 * dt) = pk4_fp8(o[dt][qt][0] * inv8, o[dt][qt][1] * inv8, o[dt][qt][2] * inv8, o[dt][qt][3] * inv8);
        }
    }
}

constexpr int RT_KS = 528, RT_VS = 144, RT_K = 0, RT_V = 128 * RT_KS, RT_VD = RT_V + 128 * RT_VS, RT_ST = RT_VD + 128 * RT_VS, RT_END = RT_ST + 64 * RT_KS;
static_assert(RT_END <= LDS_BYTES, "retention LDS");
__device__ __forceinline__ void ret_phase(LAS unsigned char* lds, const bf16_t* Qr, const bf16_t* Kr, const bf16_t* Vr, bf16_t* Yr, const float* decay_logit, int bid, int G, const int tid0) {
    const int lane0 = tid0 & 63, wid = __builtin_amdgcn_readfirstlane(tid0 >> 6), r0 = lane0 & 15, g0 = lane0 >> 4;
    constexpr float LOG2E = 1.4426950408889634f;
    const int vcu = (G % 8 == 0) ? (bid % 8) * (G / 8) + bid / 8 : bid;
    for (int it = vcu; it < NB * 4 * 8; it += G) {
        const int b = it >> 5, h = (it >> 3) & 3, db = it & 7; const size_t rowbase = (size_t)b * SEQ;
        const float lgf = logsigmoid_f(decay_logit[h]) * LOG2E, lgb = logsigmoid_f(decay_logit[4 + h]) * LOG2E;
        for (int sweep = 0; sweep < 2; ++sweep) {
            const float lg = sweep ? lgf : lgb;
            f32x4 S[2][4];
#pragma unroll
            for (int a2 = 0; a2 < 2; ++a2)
#pragma unroll
                for (int dt = 0; dt < 4; ++dt) S[a2][dt] = (f32x4){0.f, 0.f, 0.f, 0.f};
            __syncthreads();
            for (int c = tid0; c < 64 * RT_KS / 16; c += NTHREADS) *(LAS u32x4*)(lds + RT_ST + c * 16) = (u32x4){0u, 0u, 0u, 0u};
            u32x4 rk[8], rv[2];
            const bf16_t* gk = Kr + rowbase * 1024 + h * 256; const bf16_t* gv = Vr + rowbase * 2048 + h * 512 + db * 64;
#define RT_LOAD(c) do { const size_t t0_ = (size_t)(c) * 128; \
                _Pragma("unroll") for (int i_ = 0; i_ < 8; ++i_) { const int ch_ = tid + 512 * i_; rk[i_] = *(const u32x4*)(gk + (t0_ + (ch_ >> 5)) * 1024 + (ch_ & 31) * 8); } \
                _Pragma("unroll") for (int i_ = 0; i_ < 2; ++i_) { const int ch_ = tid + 512 * i_; rv[i_] = *(const u32x4*)(gv + (t0_ + (ch_ >> 3)) * 2048 + (ch_ & 7) * 8); } } while (0)
            bf16x8 qn[8];
#define RT_LOADQ(c) do { const bf16_t* qp_ = Qr + (rowbase + (size_t)(c) * 128 + wid * 16 + r) * 1024 + h * 256 + 8 * g; \
                _Pragma("unroll") for (int ks_ = 0; ks_ < 8; ++ks_) qn[ks_] = *(const bf16x8*)(qp_ + 32 * ks_); } while (0)
            { const int tid = tid0, r = r0, g = g0; RT_LOAD(sweep ? 0 : 31); RT_LOADQ(sweep ? 0 : 31); }
            for (int step = 0; step < 32; ++step) {
                const int c = sweep ? step : 31 - step;
                int tid = tid0, lane = lane0, r = r0, g = g0;
                asm volatile("" : "+v"(tid), "+v"(lane), "+v"(r), "+v"(g));
                __syncthreads();
#pragma unroll
                for (int a2 = 0; a2 < 2; ++a2)
#pragma unroll
                    for (int dt = 0; dt < 4; ++dt) { u32x2 w; w.x = pk2(S[a2][dt][0], S[a2][dt][1]); w.y = pk2(S[a2][dt][2], S[a2][dt][3]);
                        *(LAS u32x2*)(lds + RT_ST + (16 * dt + r) * RT_KS + (16 * (2 * wid + a2) + 4 * g) * 2) = w; }
#pragma unroll
                for (int i = 0; i < 8; ++i) { const int ch = tid + 512 * i; *(LAS u32x4*)(lds + RT_K + (ch >> 5) * RT_KS + (ch & 31) * 16) = rk[i]; }
#pragma unroll
                for (int i = 0; i < 2; ++i) { const int ch = tid + 512 * i, j = ch >> 3; *(LAS u32x4*)(lds + RT_V + j * RT_VS + (ch & 7) * 16) = rv[i];
                    const float kd = fexp2((sweep ? (float)(127 - j) : (float)j) * lg);
                    u32x4 w; w.x = pk2(bf_lo(rv[i].x) * kd, bf_hi(rv[i].x) * kd); w.y = pk2(bf_lo(rv[i].y) * kd, bf_hi(rv[i].y) * kd); w.z = pk2(bf_lo(rv[i].z) * kd, bf_hi(rv[i].z) * kd); w.w = pk2(bf_lo(rv[i].w) * kd, bf_hi(rv[i].w) * kd);
                    *(LAS u32x4*)(lds + RT_VD + j * RT_VS + (ch & 7) * 16) = w; }
                bf16x8 qf[8];
#pragma unroll
                for (int ks = 0; ks < 8; ++ks) qf[ks] = qn[ks];
                u32x2 ypart[4];
                if (sweep) { const bf16_t* ypl = Yr + (rowbase + (size_t)c * 128 + wid * 16 + r) * 2048 + h * 512 + db * 64 + 4 * g;
#pragma unroll
                    for (int dt = 0; dt < 4; ++dt) ypart[dt] = *(const u32x2*)(ypl + 16 * dt); }
                __syncthreads();
                const int il = wid * 16 + r;
                f32x4 acc[4];
#pragma unroll
                for (int dt = 0; dt < 4; ++dt) acc[dt] = (f32x4){0.f, 0.f, 0.f, 0.f};
#pragma unroll
                for (int ks = 0; ks < 8; ++ks)
#pragma unroll
                    for (int dt = 0; dt < 4; ++dt) { const bf16x8 sf = *(const LAS bf16x8*)(lds + RT_ST + (16 * dt + r) * RT_KS + (32 * ks + 8 * g) * 2); acc[dt] = mfma16(sf, qf[ks], acc[dt]); }
                { const float qd = fexp2((sweep ? (float)(il + 1) : (float)(128 - il)) * lg);
#pragma unroll
                  for (int dt = 0; dt < 4; ++dt) acc[dt] = acc[dt] * qd; }
                if (sweep) {
#pragma unroll
                    for (int hf = 0; hf < 2; ++hf) {
                        f32x4 sc[4];
#pragma unroll
                        for (int j4 = 0; j4 < 4; ++j4) { const int jt = 4 * hf + j4; sc[j4] = (f32x4){0.f, 0.f, 0.f, 0.f};
#pragma unroll
                            for (int ks = 0; ks < 8; ++ks) { const bf16x8 kf = *(const LAS bf16x8*)(lds + RT_K + (16 * jt + r) * RT_KS + (32 * ks + 8 * g) * 2); sc[j4] = mfma16(kf, qf[ks], sc[j4]); }
#pragma unroll
                            for (int jj = 0; jj < 4; ++jj) { const int d = il - (16 * jt + 4 * g + jj); sc[j4][jj] *= (d >= 0) ? fexp2((float)d * lgf) : fexp2((float)(-d) * lgb); }
                            asm volatile("" ::: "memory"); }
#pragma unroll
                        for (int k2 = 0; k2 < 2; ++k2) { const bf16x8 pf = pack_frag(sc[2 * k2], sc[2 * k2 + 1]);
#pragma unroll
                            for (int dt = 0; dt < 4; ++dt) { const bf16x8 vf = tr_frag(lds + RT_V, RT_VS, 32 * (2 * hf + k2), 16 * dt, lane); acc[dt] = mfma16(vf, pf, acc[dt]); } }
                        asm volatile("" ::: "memory");
                    }
                }
                { bf16_t* yp = Yr + (rowbase + (size_t)c * 128 + il) * 2048 + h * 512 + db * 64 + 4 * g;
#pragma unroll
                  for (int dt = 0; dt < 4; ++dt) { f32x4 v = acc[dt];
                      if (sweep) { const u32x2 pw = ypart[dt]; v[0] += bf_lo(pw.x); v[1] += bf_hi(pw.x); v[2] += bf_lo(pw.y); v[3] += bf_hi(pw.y); }
                      u32x2 w; w.x = pk2(v[0], v[1]); w.y = pk2(v[2], v[3]); *(u32x2*)(yp + 16 * dt) = w; } }
                if (step + 1 < 32) { RT_LOAD(sweep ? step + 1 : 30 - step); RT_LOADQ(sweep ? step + 1 : 30 - step); }
                { const float gc = fexp2(128.f * lg);
#pragma unroll
                  for (int a2 = 0; a2 < 2; ++a2)
#pragma unroll
                      for (int dt = 0; dt < 4; ++dt) S[a2][dt] = S[a2][dt] * gc; }
#pragma unroll
                for (int k2 = 0; k2 < 4; ++k2) {
                    bf16x8 vd[4];
#pragma unroll
                    for (int dt = 0; dt < 4; ++dt) vd[dt] = tr_frag(lds + RT_VD, RT_VS, 32 * k2, 16 * dt, lane);
#pragma unroll
                    for (int a2 = 0; a2 < 2; ++a2) { const bf16x8 kt = tr_frag(lds + RT_K, RT_KS, 32 * k2, 16 * (2 * wid + a2), lane);
#pragma unroll
                        for (int dt = 0; dt < 4; ++dt) S[a2][dt] = mfma16(kt, vd[dt], S[a2][dt]); }
                }
            }
#undef RT_LOAD
#undef RT_LOADQ
        }
        __syncthreads();
    }
}

constexpr int GP_LR = 0, GP_TOT = 8192, GP_END = 8192 + 4096;
__device__ __forceinline__ void gla_pre_phase(LAS unsigned char* lds, bf16_t* Qg, bf16_t* Kg, const float* LR, const float* w_a2, const float* b_a, bf16_t* QB, bf16_t* KB, float* ET, int bid, int G, const int tid) {
    const int vcu = (G % 8 == 0) ? (bid % 8) * (G / 8) + bid / 8 : bid;
    const int d = tid & 127, ig = tid >> 7;
    LAS float* lrs = (LAS float*)(lds + GP_LR); LAS float* tot = (LAS float*)(lds + GP_TOT);
    for (int it = vcu; it < NB * 4 * 64; it += G) {
        const int b = it >> 8, h = (it >> 6) & 3, c = it & 63; const size_t tok0 = (size_t)b * SEQ + (size_t)c * 64;
        float qv[16], kv[16];
#pragma unroll
        for (int tt = 0; tt < 16; ++tt) { const size_t o = (tok0 + 16 * ig + tt) * 512 + h * 128 + d; qv[tt] = bf2f(Qg[o]); kv[tt] = bf2f(Kg[o]); }
        *(LAS f32x4*)(lrs + (tid >> 3) * 32 + (tid & 7) * 4) = *(const f32x4*)(LR + (tok0 + (tid >> 3)) * 32 + (tid & 7) * 4);
        __syncthreads();
        float bl0[16], bl1[16];
        {
            float w2r[16];
#pragma unroll
            for (int rr = 0; rr < 16; ++rr) w2r[rr] = w_a2[(size_t)rr * 512 + h * 128 + d];
            const float ba = b_a[h * 128 + d]; float run = 0.f;
#pragma unroll
            for (int tt = 0; tt < 16; ++tt) { const LAS float* lp = lrs + (16 * ig + tt) * 32; float a = ba;
#pragma unroll
                for (int q4 = 0; q4 < 4; ++q4) { const f32x4 lv = *(const LAS f32x4*)(lp + 4 * q4); a += lv[0] * w2r[4 * q4] + lv[1] * w2r[4 * q4 + 1] + lv[2] * w2r[4 * q4 + 2] + lv[3] * w2r[4 * q4 + 3]; }
                run += logsigmoid_f(a) * 0.0625f; bl0[tt] = run; }
            tot[ig * 128 + d] = run;
        }
        {
            float w2r[16];
#pragma unroll
            for (int rr = 0; rr < 16; ++rr) w2r[rr] = w_a2[((size_t)16 + rr) * 512 + h * 128 + d];
            const float ba = b_a[512 + h * 128 + d];
#pragma unroll
            for (int tt = 0; tt < 16; ++tt) { const LAS float* lp = lrs + (16 * ig + tt) * 32 + 16; float a = ba;
#pragma unroll
                for (int q4 = 0; q4 < 4; ++q4) { const f32x4 lv = *(const LAS f32x4*)(lp + 4 * q4); a += lv[0] * w2r[4 * q4] + lv[1] * w2r[4 * q4 + 1] + lv[2] * w2r[4 * q4 + 2] + lv[3] * w2r[4 * q4 + 3]; }
                bl1[tt] = logsigmoid_f(a) * 0.0625f; }
            float run = 0.f;
#pragma unroll
            for (int tt = 15; tt >= 0; --tt) { run += bl1[tt]; bl1[tt] = run; }
            tot[512 + ig * 128 + d] = run;
        }
        __syncthreads();
        float off0 = 0.f, tot0 = 0.f, off1 = 0.f, tot1 = 0.f;
#pragma unroll
        for (int g2 = 0; g2 < 4; ++g2) { const float t0 = tot[g2 * 128 + d], t1 = tot[512 + g2 * 128 + d]; tot0 += t0; tot1 += t1; if (g2 < ig) off0 += t0; if (g2 > ig) off1 += t1; }
#pragma unroll
        for (int tt = 0; tt < 16; ++tt) { const size_t o = (tok0 + 16 * ig + tt) * 512 + h * 128 + d; const float b0 = bl0[tt] + off0, b1 = bl1[tt] + off1;
            Qg[o] = f2bf(qv[tt] * __expf(b0)); Kg[o] = f2bf(kv[tt] * __expf(-b0));
            QB[o] = f2bf(qv[tt] * __expf(b1)); KB[o] = f2bf(kv[tt] * __expf(-b1)); }
        if (ig == 0) { const size_t eo = ((size_t)b * 64 + c) * 512 + h * 128 + d; ET[eo] = __expf(tot0); ET[(size_t)NB * 64 * 512 + eo] = __expf(tot1); }
        __syncthreads();
    }
}
constexpr int GL_S = 272, GL_VS = 144;
constexpr int GL_QIN = 0, GL_KIN = 64 * GL_S, GL_KST = 2 * 64 * GL_S, GL_V = 3 * 64 * GL_S, GL_EBL = GL_V + 64 * GL_VS, GL_ST = GL_EBL + 512, GL_END = GL_ST + 2 * 64 * GL_S;
static_assert(GL_END <= LDS_BYTES - 64, "gla LDS");
__device__ __forceinline__ void gla_phase(LAS unsigned char* lds, const bf16_t* Qf, const bf16_t* Kf, const bf16_t* QB, const bf16_t* KB, const bf16_t* Vg, const float* ET, bf16_t* Yf, bf16_t* Yb, int bid, int G, const int tid0) {
    const int lane0 = tid0 & 63, wid = __builtin_amdgcn_readfirstlane(tid0 >> 6);
    const int vcu = (G % 8 == 0) ? (bid % 8) * (G / 8) + bid / 8 : bid;
    for (int it = vcu; it < NB * 4 * 2 * 4; it += G) {
        const int b = it >> 5, h = (it >> 3) & 3, fwd = (it >> 2) & 1, db = it & 3; const size_t rowbase = (size_t)b * SEQ;
        const bf16_t* QI = fwd ? Qf : QB; const bf16_t* KI = fwd ? Kf : KB; const float* ETz = ET + (fwd ? 0 : (size_t)NB * 64 * 512) + (size_t)b * 64 * 512 + h * 128; bf16_t* Yo = fwd ? Yf : Yb;
        f32x4 S[4];
#pragma unroll
        for (int dt = 0; dt < 4; ++dt) S[dt] = (f32x4){0.f, 0.f, 0.f, 0.f};
        __syncthreads();
        for (int c = tid0; c < 64 * GL_S / 16; c += NTHREADS) *(LAS u32x4*)(lds + GL_ST + c * 16) = (u32x4){0u, 0u, 0u, 0u};
        u32x4 rq[2], rkk[2], rvv; f32x4 re0, re1;
#define GL_LOAD(c) do { const size_t t0_ = rowbase + (size_t)(c) * 64; \
            _Pragma("unroll") for (int i_ = 0; i_ < 2; ++i_) { const int ch_ = tid + 512 * i_; const size_t o_ = (t0_ + (ch_ >> 4)) * 512 + h * 128 + (ch_ & 15) * 8; rq[i_] = *(const u32x4*)(QI + o_); rkk[i_] = *(const u32x4*)(KI + o_); } \
            rvv = *(const u32x4*)(Vg + (t0_ + (tid >> 3)) * 1024 + h * 256 + db * 64 + (tid & 7) * 8); \
            { const float* ep_ = ETz + (size_t)(c) * 512 + (tid & 15) * 8; re0 = *(const f32x4*)ep_; re1 = *(const f32x4*)(ep_ + 4); } } while (0)
        { const int tid = tid0; GL_LOAD(fwd ? 0 : 63); }
        for (int step = 0; step < 64; ++step) {
            const int c = fwd ? step : 63 - step; const size_t tok0 = rowbase + (size_t)c * 64;
            int tid = tid0, lane = lane0; asm volatile("" : "+v"(tid), "+v"(lane));
            const int r = lane & 15, g = lane >> 4;
            const LAS unsigned char* stc = lds + GL_ST + (step & 1) * 64 * GL_S; LAS unsigned char* stn = lds + GL_ST + ((step + 1) & 1) * 64 * GL_S;
            const LAS unsigned char* vs = lds + GL_V;
            __syncthreads();
#pragma unroll
            for (int i = 0; i < 2; ++i) { const int ch = tid + 512 * i, row = ch >> 4, cc = ch & 15;
                *(LAS u32x4*)(lds + GL_QIN + row * GL_S + cc * 16) = rq[i]; *(LAS u32x4*)(lds + GL_KIN + row * GL_S + cc * 16) = rkk[i];
                u32x4 w; w.x = pk2(bf_lo(rkk[i].x) * re0[0], bf_hi(rkk[i].x) * re0[1]); w.y = pk2(bf_lo(rkk[i].y) * re0[2], bf_hi(rkk[i].y) * re0[3]);
                w.z = pk2(bf_lo(rkk[i].z) * re1[0], bf_hi(rkk[i].z) * re1[1]); w.w = pk2(bf_lo(rkk[i].w) * re1[2], bf_hi(rkk[i].w) * re1[3]);
                *(LAS u32x4*)(lds + GL_KST + row * GL_S + cc * 16) = w; }
            *(LAS u32x4*)(lds + GL_V + (tid >> 3) * GL_VS + (tid & 7) * 16) = rvv;
            if (tid < 16) { LAS float* ebl = (LAS float*)(lds + GL_EBL) + tid * 8; *(LAS f32x4*)ebl = re0; *(LAS f32x4*)(ebl + 4) = re1; }
            __syncthreads();
            if (step + 1 < 64) GL_LOAD(fwd ? step + 1 : 62 - step);
            const int it4 = wid & 3, dh = wid >> 2, il = 16 * it4 + r;
            bf16x8 qf[4];
#pragma unroll
            for (int ks = 0; ks < 4; ++ks) qf[ks] = *(const LAS bf16x8*)(lds + GL_QIN + il * GL_S + (32 * ks + 8 * g) * 2);
            f32x4 acc[2]; acc[0] = (f32x4){0.f, 0.f, 0.f, 0.f}; acc[1] = (f32x4){0.f, 0.f, 0.f, 0.f};
#pragma unroll
            for (int ks = 0; ks < 4; ++ks)
#pragma unroll
                for (int dd = 0; dd < 2; ++dd) { const bf16x8 sf = *(const LAS bf16x8*)(stc + (16 * (2 * dh + dd) + r) * GL_S + (32 * ks + 8 * g) * 2); acc[dd] = mfma16(sf, qf[ks], acc[dd]); }
            f32x4 sc[4];
#pragma unroll
            for (int jt = 0; jt < 4; ++jt) { sc[jt] = (f32x4){0.f, 0.f, 0.f, 0.f};
#pragma unroll
                for (int ks = 0; ks < 4; ++ks) { const bf16x8 kf = *(const LAS bf16x8*)(lds + GL_KIN + (16 * jt + r) * GL_S + (32 * ks + 8 * g) * 2); sc[jt] = mfma16(kf, qf[ks], sc[jt]); }
#pragma unroll
                for (int jj = 0; jj < 4; ++jj) { const int j = 16 * jt + 4 * g + jj; const bool keep = fwd ? (j <= il) : (j > il); if (!keep) sc[jt][jj] = 0.f; } }
#pragma unroll
            for (int k2 = 0; k2 < 2; ++k2) { const bf16x8 pf = pack_frag(sc[2 * k2], sc[2 * k2 + 1]);
#pragma unroll
                for (int dd = 0; dd < 2; ++dd) { const bf16x8 vf = tr_frag(vs, GL_VS, 32 * k2, 16 * (2 * dh + dd), lane); acc[dd] = mfma16(vf, pf, acc[dd]); } }
            { bf16_t* yp = Yo + (tok0 + il) * 1024 + h * 256 + db * 64 + 32 * dh + 4 * g;
#pragma unroll
              for (int dd = 0; dd < 2; ++dd) { u32x2 w; w.x = pk2(acc[dd][0], acc[dd][1]); w.y = pk2(acc[dd][2], acc[dd][3]); *(u32x2*)(yp + 16 * dd) = w; } }
            { const LAS float* ebl = (const LAS float*)(lds + GL_EBL);
#pragma unroll
              for (int jj = 0; jj < 4; ++jj) { const float e = ebl[16 * wid + 4 * g + jj];
#pragma unroll
                  for (int dt = 0; dt < 4; ++dt) S[dt][jj] *= e; } }
#pragma unroll
            for (int k2 = 0; k2 < 2; ++k2) { const bf16x8 kt = tr_frag(lds + GL_KST, GL_S, 32 * k2, 16 * wid, lane);
#pragma unroll
                for (int dt = 0; dt < 4; ++dt) { const bf16x8 vf = tr_frag(vs, GL_VS, 32 * k2, 16 * dt, lane); S[dt] = mfma16(kt, vf, S[dt]); } }
#pragma unroll
            for (int dt = 0; dt < 4; ++dt) { u32x2 w; w.x = pk2(S[dt][0], S[dt][1]); w.y = pk2(S[dt][2], S[dt][3]); *(LAS u32x2*)(stn + (16 * dt + r) * GL_S + (16 * wid + 4 * g) * 2) = w; }
        }
#undef GL_LOAD
        __syncthreads();
    }
}

#define XB_TMO      128
#define XB_XCNT(j)  (256  + 64 * (j))
#define XB_XSUB(j)  (1280 + 64 * (j))
#define XB_XGEN(j)  (2304 + 64 * (j))
#define XB_TOP      3328
#define XB_TOPGEN   3392
#define XCD_BAR_WORDS 3456
#define XB_SPIN_CAP (1u << 18)

__device__ __forceinline__ unsigned xb_ld(unsigned* p)              { return __hip_atomic_load(p, __ATOMIC_RELAXED, __HIP_MEMORY_SCOPE_AGENT); }
__device__ __forceinline__ unsigned xb_add(unsigned* p, unsigned v) { return __hip_atomic_fetch_add(p, v, __ATOMIC_RELAXED, __HIP_MEMORY_SCOPE_AGENT); }
__device__ __forceinline__ unsigned xb_xcc_id() { return (unsigned)__builtin_amdgcn_s_getreg((3 << 11) | 20) & 0xFu; }
#define XB_SPIN(cond, bar) do { unsigned _sp = 0; while (cond) { __builtin_amdgcn_s_sleep(1); \
    if ((++_sp & 255u) == 0u) { if (xb_ld(&(bar)[XB_TMO])) break; if (_sp > XB_SPIN_CAP) { atomicAdd(&(bar)[XB_TMO], 1u); break; } } } } while (0)

struct XcdBarrier {
    unsigned* bar; unsigned x;
    volatile LAS unsigned* st;
};

__device__ __forceinline__ XcdBarrier xcd_barrier_post(unsigned* bar, volatile LAS unsigned* st) {
    XcdBarrier b; b.bar = bar; b.x = xb_xcc_id(); b.st = st;
    if (threadIdx.x == 0) (void)xb_add(&bar[XB_XCNT(b.x)], 1u);
    return b;
}
__device__ __forceinline__ void xcd_barrier_complete(unsigned* bar, unsigned x, unsigned& nloc, unsigned& nx) {
    const unsigned G = gridDim.x * gridDim.y * gridDim.z;
    unsigned sum, cnt, mine, sp = 0u;
    for (;;) {
        sum = 0u; cnt = 0u; mine = 0u;
#pragma unroll
        for (unsigned j = 0; j < 16; ++j) { const unsigned c = xb_ld(&bar[XB_XCNT(j)]); sum += c; cnt += (c > 0u) ? 1u : 0u; mine = (j == x) ? c : mine; }
        if (sum == G) break;
        __builtin_amdgcn_s_sleep(1);
        if ((++sp & 255u) == 0u) { if (xb_ld(&bar[XB_TMO])) break; if (sp > XB_SPIN_CAP) { atomicAdd(&bar[XB_TMO], 1u); break; } }
    }
    nloc = mine > 0u ? mine : 1u; nx = cnt > 0u ? cnt : 1u;
}

__device__ __forceinline__ void xcd_barrier(const XcdBarrier& b) {
    asm volatile("s_waitcnt vmcnt(0)" ::: "memory");
    __syncthreads();
    if (threadIdx.x == 0) {
        unsigned* bar = b.bar;
        __builtin_amdgcn_s_waitcnt(0);
        unsigned nloc = b.st[0], nx = b.st[1];
        if (nloc == 0u) { xcd_barrier_complete(bar, b.x, nloc, nx); b.st[0] = nloc; b.st[1] = nx; }
        const unsigned old = xb_add(&bar[XB_XSUB(b.x)], 1u);
        const unsigned gen = old / nloc;
        if (old + 1u == (gen + 1u) * nloc) {
            __builtin_amdgcn_fence(__ATOMIC_RELEASE, "agent");
            asm volatile("s_waitcnt vmcnt(0)" ::: "memory");
            const unsigned og = xb_add(&bar[XB_TOP], 1u);
            const unsigned tg = og / nx;
            if (og + 1u == (tg + 1u) * nx) xb_add(&bar[XB_TOPGEN], 1u);
            else XB_SPIN(xb_ld(&bar[XB_TOPGEN]) == tg, bar);
            __builtin_amdgcn_fence(__ATOMIC_ACQUIRE, "agent");
            xb_add(&bar[XB_XGEN(b.x)], 1u);
            asm volatile("s_waitcnt vmcnt(0)" ::: "memory");
        } else {
            XB_SPIN(xb_ld(&bar[XB_XGEN(b.x)]) == gen, bar);
            __builtin_amdgcn_fence(__ATOMIC_ACQUIRE, "agent");
            asm volatile("s_waitcnt vmcnt(0)" ::: "memory");
        }
    }
    __syncthreads();
}

constexpr size_t WS_BAR = 0, WS_BAR_BYTES = 65536;
constexpr int LDS_BARST = LDS_BYTES - 64;
#ifndef N_LAUNCH_PER_PHASE
#define N_LAUNCH_PER_PHASE 0
#endif
#ifndef DBG_RET
#define DBG_RET 0
#endif
#ifndef DBG_NOMIX
#define DBG_NOMIX 0
#endif
#ifndef OPMASK
#define OPMASK 0xFFF
#endif
enum { OP_PRO, OP_DOWN, OP_UQ, OP_SG, OP_ATTN, OP_LN, OP_FFNIN, OP_RETQKV, OP_RETCORE, OP_RETGATE, OP_GLACORE, OP_GLAGATE, OP_GLAPRE };
enum { SG_UKV, SG_MLAWO, SG_FFNOUT, SG_RETG, SG_RETWO, SG_GLAIN, SG_GLAWO };
struct Ph { unsigned char op, sub, layer, sync; };
#define MLA_LAYER(L) {OP_DOWN, 0, L, 1}, {OP_UQ, 0, L, 0}, {OP_SG, SG_UKV, L, 1}, {OP_ATTN, 0, L, 1}, {OP_SG, SG_MLAWO, L, 1}
#define FFN_PART(L) {OP_LN, 0, L, 1}, {OP_FFNIN, 0, L, 1}, {OP_SG, SG_FFNOUT, L, 1}, {OP_LN, 1, L, 1}
__device__ const Ph PHASES[] = {
    {OP_PRO, 0, 0, 1},
    MLA_LAYER(0), FFN_PART(0),
    {OP_RETQKV, 0, 1, 1}, {OP_RETCORE, 0, 1, 1}, {OP_SG, SG_RETG, 1, 1}, {OP_RETGATE, 0, 1, 1}, {OP_SG, SG_RETWO, 1, 1}, FFN_PART(1),
    {OP_SG, SG_GLAIN, 2, 1}, {OP_GLAPRE, 0, 2, 1}, {OP_GLACORE, 0, 2, 1}, {OP_GLAGATE, 0, 2, 1}, {OP_SG, SG_GLAWO, 2, 1}, FFN_PART(2),
    MLA_LAYER(3), FFN_PART(3),
};
constexpr int N_PHASES = 1 + 9 + 9 + 9 + 9;

__global__ void __launch_bounds__(NTHREADS, 2) fwd_kernel(Args args) {
#if defined(__HIP_DEVICE_COMPILE__)
    extern __shared__ __attribute__((aligned(16))) unsigned char lds_raw[];
    LAS unsigned char* lds = (LAS unsigned char*)lds_raw;
    cg::grid_group grid = cg::this_grid();
    const int ph_lo = args.ph_lo, ph_hi = args.ph_hi;
    const int wave0 = __builtin_amdgcn_readfirstlane((int)threadIdx.x >> 6);
#if !N_LAUNCH_PER_PHASE
    if (threadIdx.x < 2) ((volatile LAS unsigned*)(lds + LDS_BARST))[threadIdx.x] = 0u;
    __syncthreads();
    (void)xcd_barrier_post((unsigned*)(args.ws + WS_BAR), (volatile LAS unsigned*)(lds + LDS_BARST));
#endif
    for (int ph = ph_lo; ph < ph_hi; ++ph) {
        KArgs ap = (KArgs)__builtin_amdgcn_kernarg_segment_ptr();
        asm volatile("" : "+s"(ap));
        int wv = wave0, G = gridDim.x, bid = blockIdx.x; asm volatile("" : "+s"(wv), "+s"(G), "+s"(bid));
        unsigned char* ws = ap->ws; float* out = ap->out;
        const int wid = wv;
        const int gw = bid * NWAVES + wid, ngw = G * NWAVES;
        bf16_t* XB = (bf16_t*)(ws + WS_XB); bf16_t* Y = (bf16_t*)(ws + A_Y);
        const f32x2* tabM = (const f32x2*)(ws + WS_TABM); const f32x2* tabR = (const f32x2*)(ws + WS_TABR);
        const Ph P = PHASES[ph]; const int L = P.layer, kind = L % 3, j = L / 3;
        switch (P.op) {
#if OPMASK & (1 << 0)
        case OP_PRO: {
            const int tid = phase_tid(wv), lane = tid & 63; (void)lane;
            Cvt C{(LAS float*)(lds + wid * 8448), gw, ngw, lane, 0};
            convert_layer(C, ap, ws, 0);
            for (int row = gw; row < T; row += ngw) {
#pragma unroll
                for (int q = 0; q < 4; ++q) { const f32x4 v = *(const f32x4*)(ap->in.x + (size_t)row * DM + 4 * lane + 256 * q); *(unsigned*)((unsigned char*)XB + (size_t)row * DM + 4 * lane + 256 * q) = pk4_fp8(v[0] * X8_SCALE, v[1] * X8_SCALE, v[2] * X8_SCALE, v[3] * X8_SCALE); }
            }
            for (int e = bid * NTHREADS + tid; e < T * 32; e += G * NTHREADS) ((f32x2*)(ws + WS_TABM))[e] = rope_compute(ap->in.pos[e >> 5], e & 31, 32);
            for (int e = bid * NTHREADS + tid; e < 2 * T * 2; e += G * NTHREADS) ((float*)(ws + WS_SS))[e] = 0.f;
        } break;
#endif
#if OPMASK & (1 << 1)
        case OP_DOWN: {
            const int tid = phase_tid(wv), lane = tid & 63; (void)lane;
            pg8::Gemm gm{XB, (const bf16_t*)(ws + WS_WM + WM_MLA_DOWN), T, 1024, 512}; pg8::StaticOrder S; S.init(T, 1024, G, bid);
            EpiDown E{(bf16_t*)(ws + A_CQ), (bf16_t*)(ws + A_CKV), (bf16_t*)(ws + A_KR), (float*)(ws + WS_SS) + (size_t)j * T * 2, tabM, 1.f / (X8_SCALE * WD8_SCALE)};
            pg8::gemm_phase<EpiDown, pg8::StaticOrder, true, true, true>(lds, gm, S, E, tid);
        } break;
#endif
#if OPMASK & (1 << 2)
        case OP_UQ: {
            const int tid = phase_tid(wv), lane = tid & 63; (void)lane;
            pg8::Gemm gm{(const bf16_t*)(ws + A_CQ), (const bf16_t*)(ws + WS_WM + WM_MLA_UQ), T, 1536, 256}; pg8::StaticOrder S; S.init(T, 1536, G, bid);
            EpiUq E{(bf16_t*)(ws + A_Q), (const float*)(ws + WS_SS) + (size_t)j * T * 2, tabM, 0.07216878364870322f * 1.4426950408889634f / (C8_SCALE * WU8_SCALE)};
            pg8::gemm_phase<EpiUq, pg8::StaticOrder, true, true, true>(lds, gm, S, E, tid);
        } break;
#endif
#if OPMASK & (1 << 3)
        case OP_SG: {
            const int tid = phase_tid(wv), lane = tid & 63; (void)lane;
            pg8::Gemm gm{}; EpiStore E{}; E.nseg = 1; E.ss = nullptr; E.lr = nullptr; E.lr_pn = -1; E.ss_col = 0; E.ss_invk = 0.f;
            switch (P.sub) {
            case SG_UKV: gm = pg8::Gemm{(const bf16_t*)(ws + A_CKV), (const bf16_t*)(ws + WS_WM + WM_MLA_UKV), T, 2048, 128};
                E.s0 = Seg{(bf16_t*)(ws + A_KN), 1024, 0, 1.f / (C8_SCALE * WU8_SCALE)}; E.s1 = Seg{(bf16_t*)(ws + A_V), 1024, 4, 1.f / (C8_SCALE * WU8_SCALE)}; E.nseg = 2; E.ss = (const float*)(ws + WS_SS) + (size_t)j * T * 2; E.ss_col = 1; E.ss_invk = 1.f / 256.f; break;
            case SG_MLAWO: gm = pg8::Gemm{(const bf16_t*)(ws + A_O), (const bf16_t*)(ws + WS_WM + WM_MLA_WO), T, 1024, 512}; E.s0 = Seg{Y, 1024, 0, 1.f / (O8_SCALE * WO8_SCALE)}; break;
            case SG_FFNOUT: gm = pg8::Gemm{(const bf16_t*)(ws + A_H), (const bf16_t*)(ws + WS_WF + WF_OUT), T, 1024, FF / 2}; E.s0 = Seg{Y, 1024, 0, 1.f / (H8_SCALE * W8_SCALE)}; break;
            case SG_RETG: gm = pg8::Gemm{XB, (const bf16_t*)(ws + WS_WM + WM_RET_IN) + (size_t)4096 * 1024, T, 2048, 1024}; E.s0 = Seg{(bf16_t*)(ws + A_RG), 2048, 0, 1.f}; break;
            case SG_RETWO: gm = pg8::Gemm{(const bf16_t*)(ws + A_RA), (const bf16_t*)(ws + WS_WM + WM_RET_WO), T, 1024, 2048}; E.s0 = Seg{Y, 1024, 0, 1.f}; break;
            case SG_GLAIN: gm = pg8::Gemm{XB, (const bf16_t*)(ws + WS_WM + WM_GLA_IN), T, 3328, 1024};
                E.s0 = Seg{(bf16_t*)(ws + A_GQ), 512, 0, 0.08838834764831845f}; E.s1 = Seg{(bf16_t*)(ws + A_GK), 512, 2, 1.f}; E.s2 = Seg{(bf16_t*)(ws + A_GV), 1024, 4, 1.f}; E.s3 = Seg{(bf16_t*)(ws + A_GR), 1024, 8, 1.f}; E.nseg = 4;
                E.lr = (float*)(ws + A_GLR); E.lr_pn = 12; break;
            default: gm = pg8::Gemm{(const bf16_t*)(ws + A_GA), (const bf16_t*)(ws + WS_WM + WM_GLA_WO), T, 1024, 1024}; E.s0 = Seg{Y, 1024, 0, 1.f}; break;
            }
            pg8::StaticOrder S; S.init(T, gm.N, G, bid);
            if (P.sub == SG_FFNOUT || P.sub == SG_MLAWO || P.sub == SG_UKV) pg8::gemm_phase<EpiStore, pg8::StaticOrder, true, true, true>(lds, gm, S, E, tid);
            else pg8::gemm_phase<EpiStore, pg8::StaticOrder, true, true>(lds, gm, S, E, tid);
        } break;
#endif
#if OPMASK & (1 << 4)
        case OP_ATTN: {
            const int tid = phase_tid(wv), lane = tid & 63; (void)lane; (void)tid;
            attn_phase(lds, (const bf16_t*)(ws + A_Q), (const bf16_t*)(ws + A_KN), (const bf16_t*)(ws + A_KR), (const bf16_t*)(ws + A_V), (bf16_t*)(ws + A_O), bid, G, tid);
        } break;
#endif
#if OPMASK & (1 << 5)
        case OP_LN: {
            const int tid = phase_tid(wv), lane = tid & 63; (void)lane;
            const float* xin = (L == 0 && P.sub == 0) ? ap->in.x : out;
            ln_phase(xin, Y, ap->in.ln_g + (size_t)(L * 2 + P.sub) * DM, ap->in.ln_b + (size_t)(L * 2 + P.sub) * DM, out, XB, gw, ngw, lane, ((DBG_NOMIX >> (P.sub ? 3 : kind)) & 1) ? 0.f : 1.f, P.sub == 0 || (L + 1) % 3 == 0, P.sub == 1 && L + 1 == DEPTH);
            if (P.sub == 1 && L + 1 < DEPTH) { Cvt C{(LAS float*)(lds + wid * 8448), gw, ngw, lane, 0}; convert_layer(C, ap, ws, L + 1);
                if ((L + 1) % 3 == 1) for (int e = bid * NTHREADS + tid; e < T * 128; e += G * NTHREADS) ((f32x2*)(ws + WS_TABR))[e] = rope_compute(ap->in.pos[e >> 7], e & 127, 128); }
        } break;
#endif
#if OPMASK & (1 << 6)
        case OP_FFNIN: {
            const int tid = phase_tid(wv), lane = tid & 63; (void)lane;
            pg8::Gemm gm{XB, (const bf16_t*)(ws + WS_WF + WF_IN), T, 2 * FF, 512}; pg8::StaticOrder S; S.init(T, 2 * FF, G, bid);
            EpiSwiglu E{(bf16_t*)(ws + A_H), 1.f / (X8_SCALE * W8IN_SCALE)};
            pg8::gemm_phase<EpiSwiglu, pg8::StaticOrder, true, true, true>(lds, gm, S, E, tid);
        } break;
#endif
#if OPMASK & (1 << 7)
        case OP_RETQKV: {
            const int tid = phase_tid(wv), lane = tid & 63; (void)lane;
            pg8::Gemm gm{XB, (const bf16_t*)(ws + WS_WM + WM_RET_IN), T, 4096, 1024}; pg8::StaticOrder S; S.init(T, 4096, G, bid);
            EpiRet E{(bf16_t*)(ws + A_RQ), (bf16_t*)(ws + A_RK), (bf16_t*)(ws + A_RV), tabR};
            pg8::gemm_phase<EpiRet, pg8::StaticOrder, true, true>(lds, gm, S, E, tid);
        } break;
#endif
#if OPMASK & (1 << 8)
        case OP_RETCORE: {
            const int tid = phase_tid(wv), lane = tid & 63; (void)lane; (void)tid;
            ret_phase(lds, (const bf16_t*)(ws + A_RQ), (const bf16_t*)(ws + A_RK), (const bf16_t*)(ws + A_RV), (bf16_t*)(ws + A_RY), ap->in.ret_decay + (size_t)j * 8, bid, G, tid);
        } break;
#endif
#if OPMASK & (1 << 9)
        case OP_RETGATE: {
            const int tid = phase_tid(wv), lane = tid & 63; (void)lane; (void)tid;
            ret_gate_phase((const bf16_t*)(ws + A_RY), (const bf16_t*)(ws + A_RG), ap->in.ret_gnw + (size_t)j * 2048, ap->in.ret_gnb + (size_t)j * 2048, (bf16_t*)(ws + A_RA), gw, ngw, lane);
        } break;
#endif
#if OPMASK & (1 << 10)
        case OP_GLACORE: {
            const int tid = phase_tid(wv), lane = tid & 63; (void)lane; (void)tid;
            gla_phase(lds, (const bf16_t*)(ws + A_GQ), (const bf16_t*)(ws + A_GK), (const bf16_t*)(ws + A_GQB), (const bf16_t*)(ws + A_GKB), (const bf16_t*)(ws + A_GV), (const float*)(ws + A_GET), (bf16_t*)(ws + A_GY), (bf16_t*)(ws + A_GY2), bid, G, tid);
        } break;
#endif
#if OPMASK & (1 << 11)
        case OP_GLAGATE: {
            const int tid = phase_tid(wv), lane = tid & 63; (void)lane; (void)tid;
            gla_gate_phase((const bf16_t*)(ws + A_GY), (const bf16_t*)(ws + A_GY2), (const bf16_t*)(ws + A_GR), ap->in.gla_norm + (size_t)j * 256, (bf16_t*)(ws + A_GA), gw, ngw, lane);
        } break;
#endif
        case OP_GLAPRE: {
            const int tid = phase_tid(wv);
            gla_pre_phase(lds, (bf16_t*)(ws + A_GQ), (bf16_t*)(ws + A_GK), (const float*)(ws + A_GLR), ap->in.gla_a2 + (size_t)j * 2 * 16 * 512, ap->in.gla_ba + (size_t)j * 2 * 512, (bf16_t*)(ws + A_GQB), (bf16_t*)(ws + A_GKB), (float*)(ws + A_GET), bid, G, tid);
        } break;
        }
        (void)kind;
        if (P.sync && ph + 1 < ph_hi) {
            if (ph == 0) grid.sync();
            else { XcdBarrier xb; xb.bar = (unsigned*)(ws + WS_BAR); xb.x = xb_xcc_id(); xb.st = (volatile LAS unsigned*)(lds + LDS_BARST); xcd_barrier(xb); }
        }
        else __syncthreads();
    }
#endif
}

extern "C" void kernel_launch(void* const* d_in, const int* in_sizes, int n_in, void* d_out, int out_size, void* d_ws, size_t ws_size, hipStream_t stream) {
    static int grid = 0;
    if (grid == 0) {
        if (n_in != 23 || out_size != T * DM || ws_size < WS_END) { fprintf(stderr, "kernel_launch: unexpected shapes (n_in %d, out %d, ws %zu); nothing launched\n", n_in, out_size, ws_size); grid = -1; return; }
        int dev = 0, cus = 0, per_cu = 0;
        hipGetDevice(&dev); hipDeviceGetAttribute(&cus, hipDeviceAttributeMultiprocessorCount, dev);
        if (hipFuncSetAttribute((const void*)fwd_kernel, hipFuncAttributeMaxDynamicSharedMemorySize, LDS_BYTES) != hipSuccess) { fprintf(stderr, "kernel_launch: hipFuncSetAttribute failed\n"); grid = -1; return; }
        if (hipOccupancyMaxActiveBlocksPerMultiprocessor(&per_cu, (const void*)fwd_kernel, NTHREADS, LDS_BYTES) != hipSuccess || per_cu < 1) { fprintf(stderr, "kernel_launch: occupancy query gives %d blocks per CU\n", per_cu); per_cu = 1; }
        (void)hipGetLastError();
        grid = cus * per_cu;
        fprintf(stderr, "kernel_launch: grid %d (%d CUs x %d)\n", grid, cus, per_cu);
    }
    if (grid < 0) return;
    Args a{};
    const void** ip = (const void**)&a.in;
    for (int i = 0; i < 23; ++i) ip[i] = d_in[i];
    a.out = (float*)d_out; a.ws = (unsigned char*)d_ws;
#if N_LAUNCH_PER_PHASE
    for (int ph = 0; ph < N_PHASES; ++ph) { a.ph_lo = ph; a.ph_hi = ph + 1; hipLaunchKernelGGL(fwd_kernel, dim3(grid), dim3(NTHREADS), LDS_BYTES, stream, a); }
#else
    if (hipMemsetAsync((char*)d_ws + WS_BAR, 0, WS_BAR_BYTES, stream) != hipSuccess) { fprintf(stderr, "kernel_launch: memset of the barrier words failed\n"); return; }
    a.ph_lo = 0; a.ph_hi = N_PHASES;
    void* kargs[] = {&a};
    const hipError_t e = hipLaunchCooperativeKernel((const void*)fwd_kernel, dim3(grid), dim3(NTHREADS), kargs, LDS_BYTES, stream);
    if (e != hipSuccess) fprintf(stderr, "kernel_launch: cooperative launch failed: %s (grid %d)\n", hipGetErrorString(e), grid);
#endif
}
```

```cpp
#include <hip/hip_runtime.h>
#include <hip/hip_cooperative_groups.h>
#include <cstdio>
#include <cstdint>
namespace cg = cooperative_groups;
namespace pg8 {
#define PG8_LAS __attribute__((address_space(3)))
typedef unsigned short bf16_t;
typedef short bf16x8 __attribute__((ext_vector_type(8)));
typedef float f32x4 __attribute__((ext_vector_type(4)));
typedef unsigned u32x4 __attribute__((ext_vector_type(4)));
constexpr int BM = 256, BK = 64, HALF = 128, HTB = HALF * BK * 2  , STAGE_BYTES = 8 * HTB, NXCD = 8, WGM = 8;

__host__ __device__ __forceinline__ int lds_byte(int r, int c) { const int st = (r >> 4) * 2 + (c >> 5), rr = r & 15, cc = c & 31, ob = rr * 64 + cc * 2; return st * 1024 + (ob ^ (((ob >> 9) & 1) << 5)); }
__host__ __device__ __forceinline__ void stage_rc(int b, int& R, int& C) { const int st = b / 1024, sb = b % 1024, swz = sb ^ (((sb >> 9) & 1) << 5); R = (st >> 1) * 16 + swz / 64; C = (st & 1) * 32 + (swz % 64) / 2; }
__host__ __device__ __forceinline__ int perm32(int rho) { const int n = rho >> 4, i = rho & 15; return 8 * (i >> 2) + 4 * n + (i & 3); }

struct Unit { int pm, pn; };
struct Gemm { const bf16_t* A; const bf16_t* Bt; int M, N, K; };

struct StaticOrder {
    int nM, nN, nwg, G, c;
    __host__ __device__ void init(int M, int N, int G_, int c_) { nM = M / BM; nN = N / BM; nwg = nM * nN; G = G_; c = c_; }
    __host__ __device__ bool next(int i, Unit& u) const {
        const long L = (long)i * G + c; if (L >= nwg) return false;
        int wgid = (int)L; { const int q = nwg / NXCD, r = nwg % NXCD, xcd = wgid % NXCD, off = wgid / NXCD; wgid = (xcd < r ? xcd * (q + 1) : r * (q + 1) + (xcd - r) * q) + off; }
        const int nig = WGM * nN, gid = wgid / nig, fm = gid * WGM, gsz = (nM - fm) < WGM ? (nM - fm) : WGM;
        u.pm = fm + ((wgid % nig) % gsz); u.pn = (wgid % nig) / gsz; return true;
    }
    __device__ __forceinline__ void a_ready(const Unit&) const {}
    __device__ __forceinline__ void done(const Unit&) const {}
};

__device__ __forceinline__ unsigned cvt_pk_bf16(float lo, float hi) { unsigned r; asm volatile("v_cvt_pk_bf16_f32 %0, %1, %2" : "=v"(r) : "v"(lo), "v"(hi)); return r; }
typedef float f32x2 __attribute__((ext_vector_type(2)));
template <class Epi, class Sched, bool ALIGN_EPI = false, bool SP2 = false, bool F8 = false>
__device__ __forceinline__ void gemm_phase(PG8_LAS unsigned char* lds, const Gemm g, const Sched& S, const Epi& E, const int tid) {
    const int wid = __builtin_amdgcn_readfirstlane(tid >> 6), lane = tid & 63, wr = wid >> 2, wc = wid & 3, fr = lane & 15, fq = lane >> 4;
    const int K = g.K, nt = K / BK;
    unsigned voffA[2], voffB[2];
#pragma unroll
    for (int i = 0; i < 2; ++i) { int R, C; stage_rc(tid * 16 + i * 8192, R, C); const int Rb = Epi::PERM ? ((R & ~31) + perm32(R & 31)) : R;
        voffA[i] = (unsigned)(R * K + C) * 2u; voffB[i] = (unsigned)(Rb * K + C) * 2u; }
    const size_t kstep = (size_t)(BK * 2);
    const size_t hstep = (size_t)HALF * K * 2;
    const size_t tstep = 2 * hstep;
    const unsigned ldsw = (unsigned)wid * 1024u;
    const int aoff = lds_byte(wr * 64 + fr, fq * 8), boff = lds_byte(wc * 32 + fr, fq * 8);
#define PG8_SA(b, h) (((b) * 2 + (h)) * HTB)
#define PG8_SB(b, h) ((4 + (b) * 2 + (h)) * HTB)
#define PG8_STAGE(bufoff, gbase, voff) do { _Pragma("unroll") for (int _i = 0; _i < 2; ++_i) \
        __builtin_amdgcn_global_load_lds((const unsigned*)((const char*)(gbase) + (voff)[_i]), (PG8_LAS unsigned*)(lds + (bufoff) + ldsw + _i * 8192), 16, 0, 0); } while (0)
#define PG8_LDA(dst, b, h) do { if constexpr (F8) { _Pragma("unroll") for (int m = 0; m < 4; ++m) dst##8[m] = __builtin_shufflevector(*(const PG8_LAS v4i_*)(lds + PG8_SA(b, h) + aoff + m * 2048), *(const PG8_LAS v4i_*)(lds + PG8_SA(b, h) + aoff + m * 2048 + 1024), 0, 1, 2, 3, 4, 5, 6, 7); } \
        else { _Pragma("unroll") for (int m = 0; m < 4; ++m) _Pragma("unroll") for (int k = 0; k < 2; ++k) dst[m][k] = *(const PG8_LAS bf16x8*)(lds + PG8_SA(b, h) + aoff + m * 2048 + k * 1024); } } while (0)
#define PG8_LDB(dst, b, h) do { if constexpr (F8) { _Pragma("unroll") for (int n = 0; n < 2; ++n) dst##8[n] = __builtin_shufflevector(*(const PG8_LAS v4i_*)(lds + PG8_SB(b, h) + boff + n * 2048), *(const PG8_LAS v4i_*)(lds + PG8_SB(b, h) + boff + n * 2048 + 1024), 0, 1, 2, 3, 4, 5, 6, 7); } \
        else { _Pragma("unroll") for (int n = 0; n < 2; ++n) _Pragma("unroll") for (int k = 0; k < 2; ++k) dst[n][k] = *(const PG8_LAS bf16x8*)(lds + PG8_SB(b, h) + boff + n * 2048 + k * 1024); } } while (0)
#define PG8_MMA(ai, bj, At, Bt) do { __builtin_amdgcn_s_setprio(1); \
        if constexpr (F8) { _Pragma("unroll") for (int m = 0; m < 4; ++m) _Pragma("unroll") for (int n = 0; n < 2; ++n) \
                asm volatile("v_mfma_scale_f32_16x16x128_f8f6f4 %0, %1, %2, %0, %3, %3 op_sel_hi:[0,0,0]" : "+v"(acc[ai][bj][m][n]) : "v"(Bt##8[n]), "v"(At##8[m]), "v"(f8one)); \
        } else { _Pragma("unroll") for (int m = 0; m < 4; ++m) _Pragma("unroll") for (int n = 0; n < 2; ++n) _Pragma("unroll") for (int k = 0; k < 2; ++k) \
            acc[ai][bj][m][n] = __builtin_amdgcn_mfma_f32_16x16x32_bf16(Bt[n][k], At[m][k], acc[ai][bj][m][n], 0, 0, 0); } \
        __builtin_amdgcn_s_setprio(0); } while (0)
#define PG8_WAIT_V(n) asm volatile("s_waitcnt vmcnt(" #n ")" ::: "memory")
#define PG8_WAIT_L(n) asm volatile("s_waitcnt lgkmcnt(" #n ")" ::: "memory")
#define PG8_BAR __builtin_amdgcn_s_barrier()
#define PG8_SCHED __builtin_amdgcn_sched_barrier(0)
    Unit cur, nxt; int ui = 0;
    if (!S.next(0, cur)) return;
    f32x4 acc[2][2][4][2];
#pragma unroll
    for (int a = 0; a < 2; ++a)
#pragma unroll
        for (int b = 0; b < 2; ++b)
#pragma unroll
            for (int m = 0; m < 4; ++m)
#pragma unroll
                for (int n = 0; n < 2; ++n) acc[a][b][m][n] = (f32x4){0.f, 0.f, 0.f, 0.f};
    typedef int v4i_ __attribute__((ext_vector_type(4))); typedef int v8i_ __attribute__((ext_vector_type(8)));
    bf16x8 At[4][2], B0[2][2], B1[2][2]; v8i_ At8[4], B08[2], B18[2]; const int f8one = 0x7f7f7f7f;
    const char* cA = (const char*)g.A + (size_t)cur.pm * tstep; const char* cB = (const char*)g.Bt + (size_t)cur.pn * tstep;
    S.a_ready(cur);
    if constexpr (SP2) {
        PG8_STAGE(PG8_SB(0, 0), cB, voffB); PG8_STAGE(PG8_SB(0, 1), cB + hstep, voffB); PG8_STAGE(PG8_SA(0, 0), cA, voffA); PG8_STAGE(PG8_SA(0, 1), cA + hstep, voffA);
        if (wr == 1) PG8_BAR;
        PG8_WAIT_V(2); PG8_BAR;
        PG8_STAGE(PG8_SB(1, 0), cB + kstep, voffB); PG8_STAGE(PG8_SA(1, 0), cA + kstep, voffA); PG8_STAGE(PG8_SB(1, 1), cB + hstep + kstep, voffB);
        PG8_WAIT_V(6); PG8_BAR;
    } else {
        PG8_STAGE(PG8_SB(0, 0), cB, voffB); PG8_STAGE(PG8_SA(0, 0), cA, voffA); PG8_STAGE(PG8_SB(0, 1), cB + hstep, voffB); PG8_STAGE(PG8_SA(0, 1), cA + hstep, voffA);
        if (wr == 1) PG8_BAR;
        PG8_WAIT_V(4); PG8_BAR;
        PG8_STAGE(PG8_SB(1, 0), cB + kstep, voffB); PG8_STAGE(PG8_SA(1, 0), cA + kstep, voffA); PG8_STAGE(PG8_SB(1, 1), cB + hstep + kstep, voffB);
        PG8_WAIT_V(6); PG8_BAR;
    }
    for (;;) {
        const bool has_next = S.next(ui + 1, nxt);
        const char* nA = has_next ? (const char*)g.A + (size_t)nxt.pm * tstep : cA; const char* nB = has_next ? (const char*)g.Bt + (size_t)nxt.pn * tstep : cB;
        for (int t = 0; t < nt; t += 2) {
            const bool last = (t == nt - 2);
            const char* a1 = cA + (size_t)(t + 1) * kstep;
            const char* a2 = last ? nA : cA + (size_t)(t + 2) * kstep; const char* b2 = last ? nB : cB + (size_t)(t + 2) * kstep;
            const char* a3 = a2 + kstep; const char* b3 = b2 + kstep;
            if (last && has_next) S.a_ready(nxt);
            if constexpr (SP2) {
            PG8_LDB(B0, 0, 0); PG8_LDB(B1, 0, 1); PG8_SCHED; PG8_LDA(At, 0, 0); PG8_STAGE(PG8_SA(1, 1), a1 + hstep, voffA);
            PG8_WAIT_V(8); PG8_WAIT_L(0); PG8_BAR; PG8_MMA(0, 0, At, B0); PG8_MMA(0, 1, At, B1); PG8_BAR; PG8_SCHED;
            PG8_LDA(At, 0, 1); PG8_STAGE(PG8_SB(0, 0), b2, voffB); PG8_STAGE(PG8_SB(0, 1), b2 + hstep, voffB); PG8_STAGE(PG8_SA(0, 0), a2, voffA);
            PG8_WAIT_V(8); PG8_WAIT_L(0); PG8_BAR; PG8_MMA(1, 0, At, B0); PG8_MMA(1, 1, At, B1); PG8_BAR; PG8_SCHED;
            PG8_LDB(B0, 1, 0); PG8_LDB(B1, 1, 1); PG8_SCHED; PG8_LDA(At, 1, 0); PG8_STAGE(PG8_SA(0, 1), a2 + hstep, voffA);
            PG8_WAIT_V(8); PG8_WAIT_L(0); PG8_BAR; PG8_MMA(0, 0, At, B0); PG8_MMA(0, 1, At, B1); PG8_BAR; PG8_SCHED;
            PG8_LDA(At, 1, 1); PG8_STAGE(PG8_SB(1, 0), b3, voffB); PG8_STAGE(PG8_SB(1, 1), b3 + hstep, voffB); PG8_STAGE(PG8_SA(1, 0), a3, voffA);
            PG8_WAIT_V(8); PG8_WAIT_L(0); PG8_BAR; PG8_MMA(1, 0, At, B0); PG8_MMA(1, 1, At, B1); PG8_BAR; PG8_SCHED;
            } else {
            PG8_LDB(B0, 0, 0); PG8_SCHED; PG8_LDA(At, 0, 0); PG8_STAGE(PG8_SA(1, 1), a1 + hstep, voffA);
            PG8_WAIT_L(8); PG8_BAR; PG8_WAIT_L(0); PG8_MMA(0, 0, At, B0); PG8_BAR; PG8_SCHED;
            PG8_LDB(B1, 0, 1); PG8_STAGE(PG8_SB(0, 0), b2, voffB);
            PG8_BAR; PG8_WAIT_L(0); PG8_MMA(0, 1, At, B1); PG8_BAR;
            PG8_LDA(At, 0, 1); PG8_STAGE(PG8_SA(0, 0), a2, voffA);
            PG8_BAR; PG8_WAIT_L(0); PG8_MMA(1, 0, At, B0); PG8_BAR; PG8_SCHED;
            PG8_STAGE(PG8_SB(0, 1), b2 + hstep, voffB);
            PG8_WAIT_V(6); PG8_BAR; PG8_MMA(1, 1, At, B1); PG8_BAR;
            PG8_LDB(B0, 1, 0); PG8_SCHED; PG8_LDA(At, 1, 0); PG8_STAGE(PG8_SA(0, 1), a2 + hstep, voffA);
            PG8_WAIT_L(8); PG8_BAR; PG8_WAIT_L(0); PG8_MMA(0, 0, At, B0); PG8_BAR; PG8_SCHED;
            PG8_LDB(B1, 1, 1); PG8_STAGE(PG8_SB(1, 0), b3, voffB);
            PG8_BAR; PG8_WAIT_L(0); PG8_MMA(0, 1, At, B1); PG8_BAR;
            PG8_LDA(At, 1, 1); PG8_STAGE(PG8_SA(1, 0), a3, voffA);
            PG8_BAR; PG8_WAIT_L(0); PG8_MMA(1, 0, At, B0); PG8_BAR; PG8_SCHED;
            PG8_STAGE(PG8_SB(1, 1), b3 + hstep, voffB);
            PG8_WAIT_V(6); PG8_BAR; PG8_MMA(1, 1, At, B1); PG8_BAR;
            }
        }
        if constexpr (ALIGN_EPI) { if (wr == 0) PG8_BAR; }
        if constexpr (F8) asm volatile("s_nop 15\n\ts_nop 7" ::: "memory");
        if constexpr (!Epi::AFTER_DRAIN) { E(acc, cur, wr, wc, fr, fq); S.done(cur); }
        if (!has_next) break;
#pragma unroll
        for (int a = 0; a < 2; ++a)
#pragma unroll
            for (int b = 0; b < 2; ++b)
#pragma unroll
                for (int m = 0; m < 4; ++m)
#pragma unroll
                    for (int n = 0; n < 2; ++n) acc[a][b][m][n] = (f32x4){0.f, 0.f, 0.f, 0.f};
        cur = nxt; cA = nA; cB = nB; ++ui;
        if constexpr (ALIGN_EPI) { if (wr == 1) PG8_BAR; }
    }
    PG8_WAIT_V(0);
    if constexpr (!ALIGN_EPI) { if (wr == 0) PG8_BAR; }
    PG8_BAR;
    if constexpr (Epi::AFTER_DRAIN) { E.fused(acc, cur, wr, wc, fr, fq, lds, wid, lane); S.done(cur); }
#undef PG8_SA
#undef PG8_SB
#undef PG8_STAGE
#undef PG8_LDA
#undef PG8_LDB
#undef PG8_MMA
#undef PG8_WAIT_V
#undef PG8_WAIT_L
#undef PG8_BAR
#undef PG8_SCHED
}
}

constexpr int NB = 8, SEQ = 4096, DM = 1024, T = NB * SEQ, FF = 2816, DEPTH = 4;
constexpr float LN_EPS = 1e-5f, RMS_EPS = 1e-6f;
constexpr float DN_ALPHA = 1.681792830507429f;
constexpr int NTHREADS = 512, NWAVES = 8;
constexpr int LDS_BYTES = 147456;

#define LAS __attribute__((address_space(3)))
using pg8::bf16_t; using pg8::bf16x8; using pg8::f32x4; using pg8::u32x4; using pg8::Unit;
typedef float f32x2 __attribute__((ext_vector_type(2)));
typedef unsigned u32x2 __attribute__((ext_vector_type(2)));
typedef short s16x4 __attribute__((ext_vector_type(4)));

constexpr size_t MiB = 1u << 20;
constexpr size_t WS_SS = 1 * MiB;
constexpr size_t WS_TABM = 2 * MiB;
constexpr size_t WS_TABR = 110 * MiB + 256 * MiB;
constexpr size_t WS_WM = 12 * MiB;
constexpr size_t WS_WF = 28 * MiB;
constexpr size_t WS_XB = 46 * MiB;
constexpr size_t WS_A = 110 * MiB;
constexpr size_t WS_END = 512 * MiB;
constexpr size_t A_Y = WS_A + 292 * MiB;
constexpr size_t A_CQ = WS_A, A_CKV = WS_A + 32 * MiB, A_O = WS_A, A_KR = WS_A + 64 * MiB, A_Q = WS_A + 68 * MiB, A_KN = WS_A + 164 * MiB, A_V = WS_A + 228 * MiB;
constexpr size_t A_H = WS_A;
constexpr size_t A_XH = WS_A + 100 * MiB;
constexpr size_t A_RQ = WS_A, A_RK = WS_A + 64 * MiB, A_RV = WS_A + 128 * MiB, A_RY = WS_A + 256 * MiB, A_RG = WS_A, A_RA = WS_A + 128 * MiB;
constexpr size_t A_GQ = WS_A, A_GK = WS_A + 32 * MiB, A_GV = WS_A + 64 * MiB, A_GR = WS_A + 128 * MiB, A_GLR = WS_A + 192 * MiB, A_GY = WS_A + 196 * MiB, A_GY2 = WS_A + 260 * MiB, A_GQB = WS_A + 324 * MiB, A_GKB = WS_A + 356 * MiB, A_GET = WS_A + 388 * MiB, A_GA = WS_A;
constexpr size_t WM_MLA_DOWN = 0, WM_MLA_UQ = 2 * MiB, WM_MLA_UKV = 4 * MiB, WM_MLA_WO = 5 * MiB;
constexpr size_t WM_RET_IN = 0, WM_RET_WO = 12 * MiB;
constexpr size_t WM_GLA_IN = 0, WM_GLA_WO = 7 * MiB;
constexpr size_t WF_IN = 0, WF_OUT = 11 * MiB;

typedef __bf16 bf16x2_t __attribute__((ext_vector_type(2)));
__device__ __forceinline__ unsigned pk2(float lo, float hi) { const f32x2 v = {lo, hi}; const bf16x2_t b = __builtin_convertvector(v, bf16x2_t); return __builtin_bit_cast(unsigned, b); }
__device__ __forceinline__ float bf_lo(unsigned w) { return __uint_as_float(w << 16); }
__device__ __forceinline__ float bf_hi(unsigned w) { return __uint_as_float(w & 0xffff0000u); }
__device__ __forceinline__ float bf2f(bf16_t v) { return __uint_as_float((unsigned)v << 16); }
__device__ __forceinline__ bf16_t f2bf(float f) { return (bf16_t)(pk2(f, 0.f) & 0xffffu); }
__device__ __forceinline__ unsigned pk4_fp8(float a, float b, float c, float d) {
    a = __builtin_amdgcn_fmed3f(a, -440.f, 440.f); b = __builtin_amdgcn_fmed3f(b, -440.f, 440.f); c = __builtin_amdgcn_fmed3f(c, -440.f, 440.f); d = __builtin_amdgcn_fmed3f(d, -440.f, 440.f);
    int w = __builtin_amdgcn_cvt_pk_fp8_f32(a, b, 0, false); w = __builtin_amdgcn_cvt_pk_fp8_f32(c, d, w, true); return (unsigned)w; }
constexpr float C8_SCALE = 16.f, WU8_SCALE = 256.f;
constexpr float WD8_SCALE = 512.f, O8_SCALE = 128.f, WO8_SCALE = 1024.f;
constexpr float X8_SCALE = 16.f, W8IN_SCALE = 1024.f;
constexpr float H8_SCALE = 32.f, W8_SCALE = 2048.f;
__device__ __forceinline__ void st8(bf16_t* p, f32x4 a, f32x4 b) { u32x4 w; w.x = pk2(a[0], a[1]); w.y = pk2(a[2], a[3]); w.z = pk2(b[0], b[1]); w.w = pk2(b[2], b[3]); *(u32x4*)p = w; }
template <int CTRL> __device__ __forceinline__ float dppx(float v) { return __builtin_bit_cast(float, __builtin_amdgcn_update_dpp(0, __builtin_bit_cast(int, v), CTRL, 0xF, 0xF, true)); }
__device__ __forceinline__ float sum_x16(float v) { const auto a = __builtin_amdgcn_permlane16_swap(__float_as_uint(v), __float_as_uint(v), false, false); return __uint_as_float(a[0]) + __uint_as_float(a[1]); }
__device__ __forceinline__ float sum_x32(float v) { const auto a = __builtin_amdgcn_permlane32_swap(__float_as_uint(v), __float_as_uint(v), false, false); return __uint_as_float(a[0]) + __uint_as_float(a[1]); }
__device__ __forceinline__ float max_x16(float v) { const auto a = __builtin_amdgcn_permlane16_swap(__float_as_uint(v), __float_as_uint(v), false, false); return fmaxf(__uint_as_float(a[0]), __uint_as_float(a[1])); }
__device__ __forceinline__ float max_x32(float v) { const auto a = __builtin_amdgcn_permlane32_swap(__float_as_uint(v), __float_as_uint(v), false, false); return fmaxf(__uint_as_float(a[0]), __uint_as_float(a[1])); }
__device__ __forceinline__ float wave_sum(float v, int) {
    v += dppx<0xB1>(v);
    v += dppx<0x4E>(v);
    v += dppx<0x141>(v);
    v += dppx<0x140>(v);
    v = sum_x16(v); v = sum_x32(v);
    return v;
}
__device__ __forceinline__ float fexp2(float x) { return __builtin_amdgcn_exp2f(x); }
__device__ __forceinline__ float silu_f(float g) { return g / (1.f + __expf(-g)); }
__device__ __forceinline__ float logsigmoid_f(float x) { return fminf(x, 0.f) - __logf(1.f + __expf(-fabsf(x))); }
__device__ __forceinline__ f32x4 mfma16(bf16x8 a, bf16x8 b, f32x4 c) { return __builtin_amdgcn_mfma_f32_16x16x32_bf16(a, b, c, 0, 0, 0); }
__device__ __forceinline__ s16x4 tr_read(const LAS unsigned char* p) { return __builtin_bit_cast(s16x4, __builtin_amdgcn_ds_read_tr16_b64_v4i16((LAS s16x4*)p)); }
__device__ __forceinline__ bf16x8 tr_frag(const LAS unsigned char* tile, int stride, int krow0, int col0, int lane) {
    const int g = lane >> 4, a = (lane & 15) >> 2, p = lane & 3;
    const LAS unsigned char* q = tile + (krow0 + 4 * g + a) * stride + (col0 + 4 * p) * 2;
    const s16x4 lo = tr_read(q), hi = tr_read(q + 16 * stride);
    return (bf16x8){lo[0], lo[1], lo[2], lo[3], hi[0], hi[1], hi[2], hi[3]};
}
__device__ __forceinline__ bf16x8 pack_frag(f32x4 a, f32x4 b) { u32x4 w; w.x = pk2(a[0], a[1]); w.y = pk2(a[2], a[3]); w.z = pk2(b[0], b[1]); w.w = pk2(b[2], b[3]); return __builtin_bit_cast(bf16x8, w); }

__device__ __forceinline__ f32x2 rope_compute(int pos, int i, int nfreq) {
    const float inv = powf(10000.0f, -(float)i / (float)nfreq);
    const float ang = (float)pos * inv; float s, c; sincosf(ang, &s, &c); return (f32x2){c, s};
}
struct Rope8 { f32x4 v[4]; __device__ __forceinline__ float c(int i) const { return v[i >> 1][(i & 1) * 2]; } __device__ __forceinline__ float s(int i) const { return v[i >> 1][(i & 1) * 2 + 1]; } };
__device__ __forceinline__ Rope8 rope8(const f32x2* tab, int nfreq, int row, int i0) { Rope8 r; const f32x4* p = (const f32x4*)(tab + (size_t)row * nfreq + i0);
    r.v[0] = p[0]; r.v[1] = p[1]; r.v[2] = p[2]; r.v[3] = p[3]; return r; }

#define EPI_ROW(u, ai, wr, m, fr) ((u).pm * 256 + (ai) * 128 + (wr) * 64 + (m) * 16 + (fr))
struct Seg { bf16_t* base; int ldc; int pn0; float scale; };
struct EpiStore {
    static constexpr bool PERM = true, AFTER_DRAIN = false;
    Seg s0, s1, s2, s3; int nseg;
    const float* ss; int ss_col; float ss_invk;
    float* lr; int lr_pn;
    __device__ __forceinline__ void operator()(const f32x4 (&acc)[2][2][4][2], const Unit& u, int wr, int wc, int fr, int fq) const {
        asm volatile("" : "+v"(fr), "+v"(fq));
        if (lr && u.pn == lr_pn) {
            if (wc == 0) {
#pragma unroll
                for (int ai = 0; ai < 2; ++ai)
#pragma unroll
                    for (int m = 0; m < 4; ++m) { const int row = EPI_ROW(u, ai, wr, m, fr); float* p = lr + (size_t)row * 32 + 8 * fq; *(f32x4*)p = acc[ai][0][m][0]; *(f32x4*)(p + 4) = acc[ai][0][m][1]; }
            }
            return;
        }
        Seg sg = s0; if (nseg > 1 && u.pn >= s1.pn0) sg = s1; if (nseg > 2 && u.pn >= s2.pn0) sg = s2; if (nseg > 3 && u.pn >= s3.pn0) sg = s3;
        const int colt = (u.pn - sg.pn0) * 256 + wc * 32 + 8 * fq;
#pragma unroll
        for (int ai = 0; ai < 2; ++ai)
#pragma unroll
            for (int m = 0; m < 4; ++m) {
                const int row = EPI_ROW(u, ai, wr, m, fr); float sc = sg.scale;
                if (ss) sc *= rsqrtf(ss[(size_t)row * 2 + ss_col] * ss_invk + RMS_EPS);
                bf16_t* rp = sg.base + (size_t)row * sg.ldc + colt;
#pragma unroll
                for (int bj = 0; bj < 2; ++bj) st8(rp + bj * 128, acc[ai][bj][m][0] * sc, acc[ai][bj][m][1] * sc);
            }
    }
};
struct EpiDown {
    static constexpr bool PERM = true, AFTER_DRAIN = false;
    bf16_t *CQ, *CKV, *KR; float* SS; const f32x2* tab; float inscale;
    __device__ __forceinline__ void operator()(const f32x4 (&acc)[2][2][4][2], const Unit& u, int wr, int wc, int fr, int fq) const {
        asm volatile("" : "+v"(fr), "+v"(fq));
        if (u.pn < 3) {
            bf16_t* base = u.pn < 2 ? CQ : CKV; const int ldc = u.pn < 2 ? 512 : 256, colt = (u.pn < 2 ? u.pn * 256 : 0) + wc * 32 + 8 * fq, sscol = u.pn < 2 ? 0 : 1;
#pragma unroll
            for (int ai = 0; ai < 2; ++ai)
#pragma unroll
                for (int m = 0; m < 4; ++m) {
                    const int row = EPI_ROW(u, ai, wr, m, fr); unsigned char* rp = (unsigned char*)base + (size_t)row * ldc + colt; float sq = 0.f;
#pragma unroll
                    for (int bj = 0; bj < 2; ++bj) { const f32x4 a = acc[ai][bj][m][0] * inscale, b = acc[ai][bj][m][1] * inscale;
                        { u32x2 w8; w8.x = pk4_fp8(a[0] * C8_SCALE, a[1] * C8_SCALE, a[2] * C8_SCALE, a[3] * C8_SCALE); w8.y = pk4_fp8(b[0] * C8_SCALE, b[1] * C8_SCALE, b[2] * C8_SCALE, b[3] * C8_SCALE); *(u32x2*)(rp + bj * 128) = w8; }
                        sq += (a[0] * a[0] + a[1] * a[1]) + (a[2] * a[2] + a[3] * a[3]) + (b[0] * b[0] + b[1] * b[1]) + (b[2] * b[2] + b[3] * b[3]); }
                    sq = sum_x16(sq); sq = sum_x32(sq);
                    if (fq == 0) atomicAdd(SS + (size_t)row * 2 + sscol, sq); asm volatile("" ::: "memory");
                }
        } else if (wc == 0) {
            Rope8 Rn = rope8(tab, 32, EPI_ROW(u, 0, wr, 0, fr), 8 * fq);
#pragma unroll
            for (int ai = 0; ai < 2; ++ai)
#pragma unroll
                for (int m = 0; m < 4; ++m) {
                    const int row = EPI_ROW(u, ai, wr, m, fr); const Rope8 R = Rn; f32x4 o1[2], o2[2];
                    if (ai * 4 + m < 7) Rn = rope8(tab, 32, EPI_ROW(u, (ai * 4 + m + 1) >> 2, wr, (ai * 4 + m + 1) & 3, fr), 8 * fq);
#pragma unroll
                    for (int n = 0; n < 2; ++n)
#pragma unroll
                        for (int i = 0; i < 4; ++i) { const float cc = R.c(4 * n + i), sn = R.s(4 * n + i); const float x1 = acc[ai][0][m][n][i] * inscale, x2 = acc[ai][1][m][n][i] * inscale;
                            o1[n][i] = x1 * cc - x2 * sn; o2[n][i] = x1 * sn + x2 * cc; }
                    bf16_t* rp = KR + (size_t)row * 64 + 8 * fq; st8(rp, o1[0], o1[1]); st8(rp + 32, o2[0], o2[1]); asm volatile("" ::: "memory");
                }
        }
    }
};
struct EpiUq {
    static constexpr bool PERM = true, AFTER_DRAIN = false;
    bf16_t* Q; const float* SS; const f32x2* tab; float qscale;
    __device__ __forceinline__ void operator()(const f32x4 (&acc)[2][2][4][2], const Unit& u, int wr, int wc, int fr, int fq) const {
        asm volatile("" : "+v"(fr), "+v"(fq));
        Rope8 Rn; if (u.pn >= 4) Rn = rope8(tab, 32, EPI_ROW(u, 0, wr, 0, fr), 8 * fq); else { Rn.v[0] = Rn.v[1] = Rn.v[2] = Rn.v[3] = (f32x4){0.f, 0.f, 0.f, 0.f}; }
#pragma unroll
        for (int ai = 0; ai < 2; ++ai)
#pragma unroll
            for (int m = 0; m < 4; ++m) {
                const int row = EPI_ROW(u, ai, wr, m, fr); const float rs = rsqrtf(SS[(size_t)row * 2] * (1.f / 512.f) + RMS_EPS) * qscale;
                bf16_t* rp = Q + (size_t)row * 1536;
                if (u.pn < 4) {
#pragma unroll
                    for (int bj = 0; bj < 2; ++bj) st8(rp + (2 * u.pn + bj) * 192 + wc * 32 + 8 * fq, acc[ai][bj][m][0] * rs, acc[ai][bj][m][1] * rs);
                } else {
                    const int h = 4 * (u.pn - 4) + wc; const Rope8 R = Rn; f32x4 o1[2], o2[2];
                    if (ai * 4 + m < 7) Rn = rope8(tab, 32, EPI_ROW(u, (ai * 4 + m + 1) >> 2, wr, (ai * 4 + m + 1) & 3, fr), 8 * fq);
#pragma unroll
                    for (int n = 0; n < 2; ++n)
#pragma unroll
                        for (int i = 0; i < 4; ++i) { const float cc = R.c(4 * n + i), sn = R.s(4 * n + i); const float x1 = acc[ai][0][m][n][i] * rs, x2 = acc[ai][1][m][n][i] * rs;
                            o1[n][i] = x1 * cc - x2 * sn; o2[n][i] = x1 * sn + x2 * cc; }
                    st8(rp + h * 192 + 128 + 8 * fq, o1[0], o1[1]); st8(rp + h * 192 + 160 + 8 * fq, o2[0], o2[1]); asm volatile("" ::: "memory");
                }
            }
    }
};
struct EpiRet {
    static constexpr bool PERM = true, AFTER_DRAIN = false;
    bf16_t *Q, *K, *V; const f32x2* tab;
    __device__ __forceinline__ void operator()(const f32x4 (&acc)[2][2][4][2], const Unit& u, int wr, int wc, int fr, int fq) const {
        asm volatile("" : "+v"(fr), "+v"(fq));
        if (u.pn < 8) {
            bf16_t* base = u.pn < 4 ? Q : K; const int hh = u.pn & 3; const float sc = u.pn < 4 ? 1.f : 0.0625f;
            Rope8 Rn = rope8(tab, 128, EPI_ROW(u, 0, wr, 0, fr), wc * 32 + 8 * fq);
#pragma unroll
            for (int ai = 0; ai < 2; ++ai)
#pragma unroll
                for (int m = 0; m < 4; ++m) {
                    const int row = EPI_ROW(u, ai, wr, m, fr); const Rope8 R = Rn; f32x4 o1[2], o2[2];
                    if (ai * 4 + m < 7) Rn = rope8(tab, 128, EPI_ROW(u, (ai * 4 + m + 1) >> 2, wr, (ai * 4 + m + 1) & 3, fr), wc * 32 + 8 * fq);
#pragma unroll
                    for (int n = 0; n < 2; ++n)
#pragma unroll
                        for (int i = 0; i < 4; ++i) { const float cc = R.c(4 * n + i), sn = R.s(4 * n + i); const float x1 = acc[ai][0][m][n][i] * sc, x2 = acc[ai][1][m][n][i] * sc;
                            o1[n][i] = x1 * cc - x2 * sn; o2[n][i] = x1 * sn + x2 * cc; }
                    bf16_t* rp = base + (size_t)row * 1024 + hh * 256 + wc * 32 + 8 * fq; st8(rp, o1[0], o1[1]); st8(rp + 128, o2[0], o2[1]); asm volatile("" ::: "memory");
                }
        } else {
#pragma unroll
            for (int ai = 0; ai < 2; ++ai)
#pragma unroll
                for (int m = 0; m < 4; ++m) {
                    const int row = EPI_ROW(u, ai, wr, m, fr); bf16_t* rp = V + (size_t)row * 2048 + (u.pn - 8) * 256 + wc * 32 + 8 * fq;
#pragma unroll
                    for (int bj = 0; bj < 2; ++bj) st8(rp + bj * 128, acc[ai][bj][m][0], acc[ai][bj][m][1]);
                }
        }
    }
};
struct EpiSwiglu {
    static constexpr bool PERM = true, AFTER_DRAIN = false;
    bf16_t* H; float inscale;
    __device__ __forceinline__ void operator()(const f32x4 (&acc)[2][2][4][2], const Unit& u, int wr, int wc, int fr, int fq) const {
        asm volatile("" : "+v"(fr), "+v"(fq));
#pragma unroll
        for (int ai = 0; ai < 2; ++ai)
#pragma unroll
            for (int m = 0; m < 4; ++m) {
                const int row = EPI_ROW(u, ai, wr, m, fr); f32x4 o[2];
#pragma unroll
                for (int n = 0; n < 2; ++n)
#pragma unroll
                    for (int i = 0; i < 4; ++i) o[n][i] = silu_f(acc[ai][0][m][n][i] * inscale) * (acc[ai][1][m][n][i] * inscale) * H8_SCALE;
                u32x2 w8; w8.x = pk4_fp8(o[0][0], o[0][1], o[0][2], o[0][3]); w8.y = pk4_fp8(o[1][0], o[1][1], o[1][2], o[1][3]);
                *(u32x2*)((unsigned char*)H + (size_t)row * FF + u.pn * 128 + wc * 32 + 8 * fq) = w8;
            }
    }
};

struct Cvt { LAS float* scr; int gw, ngw, lane, off; };
__device__ __forceinline__ void cvt_run(Cvt& C, const float* W, int pitch, int K, int src0, bf16_t* WT, int dst0, int nrows, const float* gain, bool a1 = false, bool f8 = false, float f8s = 1.f) {
    const int nblk = nrows / 32, nitems = (K / 64) * nblk, lane = C.lane;
    int first = C.gw - (C.off % C.ngw); if (first < 0) first += C.ngw;
    for (int item = first; item < nitems; item += C.ngw) {
        const int kb = item / nblk, nb = item % nblk, k0 = 64 * kb, n0 = 32 * nb;
        if (a1) {
#pragma unroll 8
            for (int i = 0; i < 32; ++i) { const int kk = 2 * i + (lane >> 5), k = k0 + kk, c = lane & 31;
                C.scr[kk * 33 + c] = W[(size_t)(c >> 4) * K * 16 + (size_t)k * 16 + (c & 15)]; }
        } else {
#pragma unroll
            for (int i = 0; i < 8; ++i) { const int kk = 8 * i + (lane >> 3), k = k0 + kk, c = (lane & 7) * 4;
                f32x4 v = *(const f32x4*)(W + (size_t)k * pitch + src0 + n0 + c);
                if (gain) v = v * gain[k];
                LAS float* sp = C.scr + kk * 33 + c; sp[0] = v[0]; sp[1] = v[1]; sp[2] = v[2]; sp[3] = v[3]; }
        }
        asm volatile("s_waitcnt lgkmcnt(0)" ::: "memory");
        const int c8 = lane & 7;
#pragma unroll
        for (int j = 0; j < 4; ++j) { const int n = (lane >> 3) + 8 * j; const LAS float* s = C.scr + (8 * c8) * 33 + n;
            if (f8) { u32x2 o8; o8.x = pk4_fp8(s[0 * 33] * f8s, s[1 * 33] * f8s, s[2 * 33] * f8s, s[3 * 33] * f8s); o8.y = pk4_fp8(s[4 * 33] * f8s, s[5 * 33] * f8s, s[6 * 33] * f8s, s[7 * 33] * f8s);
                *(u32x2*)((unsigned char*)WT + (size_t)(dst0 + n0 + n) * K + k0 + 8 * c8) = o8; }
            else { u32x4 o; o.x = pk2(s[0 * 33], s[1 * 33]); o.y = pk2(s[2 * 33], s[3 * 33]); o.z = pk2(s[4 * 33], s[5 * 33]); o.w = pk2(s[6 * 33], s[7 * 33]);
                *(u32x4*)(WT + (size_t)(dst0 + n0 + n) * K + k0 + 8 * c8) = o; } }
        asm volatile("s_waitcnt lgkmcnt(0)" ::: "memory");
    }
    C.off += nitems;
}
__device__ __forceinline__ void cvt_zero(Cvt& C, bf16_t* WT, int K, int dst0, int nrows) {
    const int nchunks = nrows * K / 8;
    for (int c = C.gw * 64 + C.lane; c < nchunks; c += C.ngw * 64) *(u32x4*)(WT + (size_t)dst0 * K + (size_t)c * 8) = (u32x4){0u, 0u, 0u, 0u};
}
struct Inputs { const float* x; const int* pos; const float *ln_g, *ln_b, *ffn_in, *ffn_out, *mla_down, *mla_qn, *mla_uq, *mla_kvn, *mla_ukv, *mla_wo,
                *ret_in, *ret_decay, *ret_gnw, *ret_gnb, *ret_wo, *gla_in, *gla_a1, *gla_a2, *gla_ba, *gla_norm, *gla_wo; };
__device__ __forceinline__ int phase_tid(int wv) { int t; asm volatile("v_mbcnt_lo_u32_b32 %0, -1, 0\n\tv_mbcnt_hi_u32_b32 %0, -1, %0" : "=v"(t)); return t + wv * 64; }
struct Args { Inputs in; float* out; unsigned char* ws; int ph_lo, ph_hi; };
typedef const __attribute__((address_space(4))) Args* KArgs;
#if defined(__HIP_DEVICE_COMPILE__)
__device__ __forceinline__ void convert_layer(Cvt& C, KArgs ap, unsigned char* ws, int L) {
    const int kind = L % 3, j = L / 3;
    bf16_t* wm = (bf16_t*)(ws + WS_WM);
    if (kind == 0) {
        const float* wd = ap->in.mla_down + (size_t)j * 1024 * 832; bf16_t* d = (bf16_t*)(ws + WS_WM + WM_MLA_DOWN);
        cvt_run(C, wd, 832, 1024, 0, d, 0, 768, nullptr, false, true, WD8_SCALE); cvt_run(C, wd, 832, 1024, 768, d, 768, 32, nullptr, false, true, WD8_SCALE); cvt_run(C, wd, 832, 1024, 800, d, 896, 32, nullptr, false, true, WD8_SCALE);
        cvt_zero(C, d, 512, 800, 96); cvt_zero(C, d, 512, 928, 96);
        const float* wq = ap->in.mla_uq + (size_t)j * 512 * 1536; const float* gq = ap->in.mla_qn + j * 512; bf16_t* q = (bf16_t*)(ws + WS_WM + WM_MLA_UQ);
        for (int h = 0; h < 8; ++h) cvt_run(C, wq, 1536, 512, h * 192, q, h * 128, 128, gq, false, true, WU8_SCALE);
        for (int t = 0; t < 2; ++t) for (int bj = 0; bj < 2; ++bj) for (int hh = 0; hh < 4; ++hh) cvt_run(C, wq, 1536, 512, (4 * t + hh) * 192 + 128 + bj * 32, q, 1024 + t * 256 + bj * 128 + hh * 32, 32, gq, false, true, WU8_SCALE);
        const float* wk = ap->in.mla_ukv + (size_t)j * 256 * 2048; const float* gk = ap->in.mla_kvn + j * 256; bf16_t* kv = (bf16_t*)(ws + WS_WM + WM_MLA_UKV);
        for (int h = 0; h < 8; ++h) { cvt_run(C, wk, 2048, 256, h * 256, kv, h * 128, 128, gk, false, true, WU8_SCALE); cvt_run(C, wk, 2048, 256, h * 256 + 128, kv, 1024 + h * 128, 128, gk, false, true, WU8_SCALE); }
        cvt_run(C, ap->in.mla_wo + (size_t)j * 1024 * 1024, 1024, 1024, 0, (bf16_t*)(ws + WS_WM + WM_MLA_WO), 0, 1024, nullptr, false, true, WO8_SCALE);
    } else if (kind == 1) {
        cvt_run(C, ap->in.ret_in + (size_t)j * 1024 * 6144, 6144, 1024, 0, (bf16_t*)(ws + WS_WM + WM_RET_IN), 0, 6144, nullptr);
        cvt_run(C, ap->in.ret_wo + (size_t)j * 2048 * 1024, 1024, 2048, 0, (bf16_t*)(ws + WS_WM + WM_RET_WO), 0, 1024, nullptr);
    } else {
        bf16_t* gi = (bf16_t*)(ws + WS_WM + WM_GLA_IN);
        cvt_run(C, ap->in.gla_in + (size_t)j * 1024 * 3072, 3072, 1024, 0, gi, 0, 3072, nullptr);
        cvt_run(C, ap->in.gla_a1 + (size_t)j * 2 * 1024 * 16, 16, 1024, 0, gi, 3072, 32, nullptr, true);
        cvt_zero(C, gi, 1024, 3104, 224);
        cvt_run(C, ap->in.gla_wo + (size_t)j * 1024 * 1024, 1024, 1024, 0, (bf16_t*)(ws + WS_WM + WM_GLA_WO), 0, 1024, nullptr);
    }
    (void)wm;
    const float* fi = ap->in.ffn_in + (size_t)L * 1024 * 5632; bf16_t* f1 = (bf16_t*)(ws + WS_WF + WF_IN);
    for (int t = 0; t < 22; ++t) { cvt_run(C, fi, 5632, 1024, 128 * t, f1, 256 * t, 128, nullptr, false, true, W8IN_SCALE); cvt_run(C, fi, 5632, 1024, 2816 + 128 * t, f1, 256 * t + 128, 128, nullptr, false, true, W8IN_SCALE); }
    cvt_run(C, ap->in.ffn_out + (size_t)L * 2816 * 1024, 1024, 2816, 0, (bf16_t*)(ws + WS_WF + WF_OUT), 0, 1024, nullptr, false, true, W8_SCALE);
}

#endif
typedef _Float16 h16x2 __attribute__((ext_vector_type(2)));
__device__ __forceinline__ f32x4 h4_to_f4(u32x2 w) { const unsigned wx = w[0], wy = w[1];
    const float a0 = (float)__builtin_bit_cast(_Float16, (unsigned short)(wx & 0xffffu)), a1 = (float)__builtin_bit_cast(_Float16, (unsigned short)(wx >> 16));
    const float b0 = (float)__builtin_bit_cast(_Float16, (unsigned short)(wy & 0xffffu)), b1 = (float)__builtin_bit_cast(_Float16, (unsigned short)(wy >> 16));
    return (f32x4){a0, a1, b0, b1}; }
__device__ __forceinline__ u32x2 f4_to_h4(f32x4 v) { u32x2 w; w.x = __builtin_bit_cast(unsigned, __builtin_convertvector((f32x2){v[0], v[1]}, h16x2)); w.y = __builtin_bit_cast(unsigned, __builtin_convertvector((f32x2){v[2], v[3]}, h16x2)); return w; }
__device__ __forceinline__ void ln_phase(const void* xin_, const bool in16, const bf16_t* y, const float* g, const float* b, void* xout_, const bool out16, bf16_t* xb, int gw, int ngw, int lane, const float ymul = 1.f, const bool f8out = false, const bool noxb = false) {
    const float* xin = (const float*)xin_; const _Float16* xin16 = (const _Float16*)xin_; float* xout = (float*)xout_; _Float16* xout16 = (_Float16*)xout_;
    f32x4 gv[4], bv[4];
#pragma unroll
    for (int j = 0; j < 4; ++j) { gv[j] = *(const f32x4*)(g + 4 * lane + 256 * j); bv[j] = *(const f32x4*)(b + 4 * lane + 256 * j); }
    constexpr int R = 4;
    for (int row = gw; row < T; row += R * ngw) {
        f32x4 xv[R][4]; u32x2 yv[R][4];
#pragma unroll
        for (int h = 0; h < R; ++h) { const int rr = (row + h * ngw < T) ? row + h * ngw : row;
#pragma unroll
            for (int j = 0; j < 4; ++j) { if (in16) xv[h][j] = h4_to_f4(*(const u32x2*)(xin16 + (size_t)rr * DM + 4 * lane + 256 * j)); else xv[h][j] = *(const f32x4*)(xin + (size_t)rr * DM + 4 * lane + 256 * j);
                yv[h][j] = *(const u32x2*)(y + (size_t)rr * DM + 4 * lane + 256 * j); } }
#pragma unroll
        for (int h = 0; h < R; ++h) {
            const int rr = row + h * ngw;
            if (rr < T) {
                f32x4 v[4]; float s = 0.f;
#pragma unroll
                for (int j = 0; j < 4; ++j) { const f32x4 xq = xv[h][j]; const u32x2 yw = yv[h][j];
                    v[j] = (f32x4){DN_ALPHA * xq[0] + ymul * bf_lo(yw.x), DN_ALPHA * xq[1] + ymul * bf_hi(yw.x), DN_ALPHA * xq[2] + ymul * bf_lo(yw.y), DN_ALPHA * xq[3] + ymul * bf_hi(yw.y)};
                    s += (v[j][0] + v[j][1]) + (v[j][2] + v[j][3]); }
                const float mean = wave_sum(s, lane) * (1.f / DM); float q = 0.f;
#pragma unroll
                for (int j = 0; j < 4; ++j) { v[j] = v[j] - mean; q += (v[j][0] * v[j][0] + v[j][1] * v[j][1]) + (v[j][2] * v[j][2] + v[j][3] * v[j][3]); }
                const float rstd = rsqrtf(wave_sum(q, lane) * (1.f / DM) + LN_EPS);
#pragma unroll
                for (int j = 0; j < 4; ++j) { const f32x4 o = v[j] * rstd * gv[j] + bv[j];
                    if (out16) *(u32x2*)(xout16 + (size_t)rr * DM + 4 * lane + 256 * j) = f4_to_h4(o); else *(f32x4*)(xout + (size_t)rr * DM + 4 * lane + 256 * j) = o;
                    if (noxb) { }
                    else if (f8out) *(unsigned*)((unsigned char*)xb + (size_t)rr * DM + 4 * lane + 256 * j) = pk4_fp8(o[0] * X8_SCALE, o[1] * X8_SCALE, o[2] * X8_SCALE, o[3] * X8_SCALE);
                    else { u32x2 w; w.x = pk2(o[0], o[1]); w.y = pk2(o[2], o[3]); *(u32x2*)(xb + (size_t)rr * DM + 4 * lane + 256 * j) = w; } }
            }
        }
    }
}
__device__ __forceinline__ void ret_gate_phase(const bf16_t* y, const bf16_t* g, const float* gnw, const float* gnb, bf16_t* a, int gw, int ngw, int lane) {
    for (int row = gw; row < T; row += ngw) {
        u32x4 yq[4], gq4[4];
#pragma unroll
        for (int h = 0; h < 4; ++h) { const size_t off = (size_t)row * 2048 + 512 * h + 8 * lane; yq[h] = *(const u32x4*)(y + off); gq4[h] = *(const u32x4*)(g + off); }
#pragma unroll
        for (int h = 0; h < 4; ++h) {
            const size_t off = (size_t)row * 2048 + 512 * h + 8 * lane;
            const u32x4 yw = yq[h], gq = gq4[h];
            float v[8] = {bf_lo(yw.x), bf_hi(yw.x), bf_lo(yw.y), bf_hi(yw.y), bf_lo(yw.z), bf_hi(yw.z), bf_lo(yw.w), bf_hi(yw.w)};
            const float gg[8] = {bf_lo(gq.x), bf_hi(gq.x), bf_lo(gq.y), bf_hi(gq.y), bf_lo(gq.z), bf_hi(gq.z), bf_lo(gq.w), bf_hi(gq.w)};
            float s = 0.f;
#pragma unroll
            for (int i = 0; i < 8; ++i) s += v[i];
            const float mean = wave_sum(s, lane) * (1.f / 512.f); float q = 0.f;
#pragma unroll
            for (int i = 0; i < 8; ++i) { v[i] -= mean; q += v[i] * v[i]; }
            const float rstd = rsqrtf(wave_sum(q, lane) * (1.f / 512.f) + LN_EPS);
            const f32x4 w0 = *(const f32x4*)(gnw + 512 * h + 8 * lane), w1 = *(const f32x4*)(gnw + 512 * h + 8 * lane + 4), b0 = *(const f32x4*)(gnb + 512 * h + 8 * lane), b1 = *(const f32x4*)(gnb + 512 * h + 8 * lane + 4);
            f32x4 o0, o1;
#pragma unroll
            for (int i = 0; i < 4; ++i) { o0[i] = silu_f(gg[i]) * (v[i] * rstd * w0[i] + b0[i]); o1[i] = silu_f(gg[4 + i]) * (v[4 + i] * rstd * w1[i] + b1[i]); }
            st8(a + off, o0, o1);
        }
    }
}
__device__ __forceinline__ void gla_gate_phase(const bf16_t* y, const bf16_t* y2, const bf16_t* r, const float* ng, bf16_t* a, int gw, int ngw, int lane) {
    const f32x4 nv = *(const f32x4*)(ng + 4 * lane);
    for (int row = gw; row < T; row += ngw) {
#pragma unroll
        for (int h = 0; h < 4; ++h) {
            const size_t off = (size_t)row * 1024 + 256 * h + 4 * lane;
            const u32x2 yw = *(const u32x2*)(y + off), yw2 = *(const u32x2*)(y2 + off), rw = *(const u32x2*)(r + off);
            const float v[4] = {bf_lo(yw.x) + bf_lo(yw2.x), bf_hi(yw.x) + bf_hi(yw2.x), bf_lo(yw.y) + bf_lo(yw2.y), bf_hi(yw.y) + bf_hi(yw2.y)}; const float rr[4] = {bf_lo(rw.x), bf_hi(rw.x), bf_lo(rw.y), bf_hi(rw.y)};
            const float q = (v[0] * v[0] + v[1] * v[1]) + (v[2] * v[2] + v[3] * v[3]);
            const float rs = rsqrtf(wave_sum(q, lane) * (1.f / 256.f) + RMS_EPS);
            u32x2 w; w.x = pk2(silu_f(rr[0]) * v[0] * rs * nv[0], silu_f(rr[1]) * v[1] * rs * nv[1]); w.y = pk2(silu_f(rr[2]) * v[2] * rs * nv[2], silu_f(rr[3]) * v[3] * rs * nv[3]);
            *(u32x2*)(a + off) = w;
        }
    }
}

constexpr int AT_KS = 400, AT_VS = 288, AT_KB = 64 * AT_KS, AT_BUF = AT_KB + 64 * AT_VS;
static_assert(3 * AT_BUF <= LDS_BYTES - 64, "attention LDS");
__device__ __forceinline__ void attn_phase(LAS unsigned char* lds, const bf16_t* Q, const bf16_t* KN, const bf16_t* KR, const bf16_t* V, bf16_t* O, int bid, int G, const int tid) {
    const int lane_ = tid & 63, wid = __builtin_amdgcn_readfirstlane(tid >> 6), r_ = lane_ & 15, g_ = lane_ >> 4;
    const int vcu = (G % 8 == 0) ? (bid % 8) * (G / 8) + bid / 8 : bid;
    const bool late = wid >= 4;
    constexpr int NT = SEQ / 64;
    for (int it = vcu; it < NB * 8 * 16; it += G) {
        const int bh = it >> 4, qb = it & 15, b = bh >> 3, h = bh & 7; const size_t rowbase = (size_t)b * SEQ;
        bf16x8 qf[2][6];
        { const int r = r_, g = g_; const bf16_t* qp = Q + (rowbase + qb * 256 + wid * 32 + r) * 1536 + h * 192 + 8 * g;
#pragma unroll
          for (int qt = 0; qt < 2; ++qt)
#pragma unroll
              for (int s = 0; s < 6; ++s) qf[qt][s] = *(const bf16x8*)(qp + (size_t)qt * 16 * 1536 + 32 * s); }
        f32x4 o[8][2];
#pragma unroll
        for (int dt = 0; dt < 8; ++dt) { o[dt][0] = (f32x4){0.f, 0.f, 0.f, 0.f}; o[dt][1] = (f32x4){0.f, 0.f, 0.f, 0.f}; }
        float mrow[2] = {0.f, 0.f}, lrow[2] = {0.f, 0.f};
        u32x4 rk[2], rr, rv[2];
        const int c0_ = tid, c1_ = tid + 512;
        const bf16_t* gk = KN + rowbase * 1024 + h * 128; const bf16_t* gr = KR + rowbase * 64; const bf16_t* gv = V + rowbase * 1024 + h * 128;
#define AT_LOAD(t) do { const size_t k0_ = (size_t)(t) * 64; \
            rk[0] = *(const u32x4*)(gk + (k0_ + (c0 >> 4)) * 1024 + (c0 & 15) * 8); rk[1] = *(const u32x4*)(gk + (k0_ + (c1 >> 4)) * 1024 + (c1 & 15) * 8); \
            rr = *(const u32x4*)(gr + (k0_ + (c0 >> 3)) * 64 + (c0 & 7) * 8); \
            rv[0] = *(const u32x4*)(gv + (k0_ + (c0 >> 4)) * 1024 + (c0 & 15) * 8); rv[1] = *(const u32x4*)(gv + (k0_ + (c1 >> 4)) * 1024 + (c1 & 15) * 8); } while (0)
#define AT_STORE(buf) do { LAS unsigned char* kb_ = lds + (buf) * AT_BUF; LAS unsigned char* vb_ = kb_ + AT_KB; \
            *(LAS u32x4*)(kb_ + (c0 >> 4) * AT_KS + (c0 & 15) * 16) = rk[0]; *(LAS u32x4*)(kb_ + (c1 >> 4) * AT_KS + (c1 & 15) * 16) = rk[1]; \
            *(LAS u32x4*)(kb_ + (c0 >> 3) * AT_KS + 256 + (c0 & 7) * 16) = rr; \
            *(LAS u32x4*)(vb_ + (c0 >> 4) * AT_VS + (c0 & 15) * 16) = rv[0]; *(LAS u32x4*)(vb_ + (c1 >> 4) * AT_VS + (c1 & 15) * 16) = rv[1]; } while (0)
#define AT_QK(kbp) do { __builtin_amdgcn_s_setprio(1); \
            { const float n0_ = -mrow[0], n1_ = -mrow[1];     \
              _Pragma("unroll") for (int kt = 0; kt < 4; ++kt) { s[kt][0] = (f32x4){n0_, n0_, n0_, n0_}; s[kt][1] = (f32x4){n1_, n1_, n1_, n1_}; } } \
            _Pragma("unroll") for (int ks = 0; ks < 6; ++ks) { \
                _Pragma("unroll") for (int kt = 0; kt < 4; ++kt) { const bf16x8 kf = *(const LAS bf16x8*)((kbp) + (16 * kt + r) * AT_KS + (32 * ks + 8 * g) * 2); \
                    s[kt][0] = mfma16(kf, qf[0][ks], s[kt][0]); s[kt][1] = mfma16(kf, qf[1][ks], s[kt][1]); } \
                if (ks & 1) asm volatile("" ::: "memory"); } \
            __builtin_amdgcn_s_setprio(0); } while (0)
#define AT_SM1(qt) do { \
            float mx = fmaxf(fmaxf(s[0][qt][0], s[0][qt][1]), fmaxf(s[0][qt][2], s[0][qt][3])); \
            _Pragma("unroll") for (int kt = 1; kt < 4; ++kt) mx = fmaxf(mx, fmaxf(fmaxf(s[kt][qt][0], s[kt][qt][1]), fmaxf(s[kt][qt][2], s[kt][qt][3]))); \
            mx = max_x16(mx); mx = max_x32(mx); \
            if (t == 0 || __any(mx > 8.f)) {     \
                const float dl = (t == 0) ? mx : fmaxf(mx, 0.f); mrow[qt] += dl; \
                if (t != 0) { const float alpha = fexp2(-dl); lrow[qt] *= alpha; \
                    _Pragma("unroll") for (int dt = 0; dt < 8; ++dt) o[dt][qt] = o[dt][qt] * alpha; } \
                _Pragma("unroll") for (int kt = 0; kt < 4; ++kt) s[kt][qt] = s[kt][qt] - dl; \
            } \
            float rs = 0.f; \
            _Pragma("unroll") for (int kt = 0; kt < 4; ++kt) \
                _Pragma("unroll") for (int j = 0; j < 4; ++j) { const float p = fexp2(s[kt][qt][j]); s[kt][qt][j] = p; rs += p; } \
            lrow[qt] += rs; \
            pf[qt][0] = pack_frag(s[0][qt], s[1][qt]); pf[qt][1] = pack_frag(s[2][qt], s[3][qt]); } while (0)
#define AT_PV(vbp) do { __builtin_amdgcn_s_setprio(1); \
            _Pragma("unroll") for (int k2 = 0; k2 < 2; ++k2) \
                _Pragma("unroll") for (int dt = 0; dt < 8; ++dt) { const bf16x8 vf = tr_frag((vbp), AT_VS, 32 * k2, 16 * dt, lane); \
                    o[dt][0] = mfma16(vf, pf[0][k2], o[dt][0]); o[dt][1] = mfma16(vf, pf[1][k2], o[dt][1]); } \
            __builtin_amdgcn_s_setprio(0); } while (0)
        bf16x8 pf[2][2];
        pf[0][0] = pf[0][1] = pf[1][0] = pf[1][1] = (bf16x8){0, 0, 0, 0, 0, 0, 0, 0};
        { int c0 = c0_, c1 = c1_; asm volatile("" : "+v"(c0), "+v"(c1));
          AT_LOAD(0);
          __syncthreads();
          AT_STORE(0);
          __syncthreads(); }
        if (!late) {
            int b_cur = 0;
            for (int t = 0; t < NT; ++t) {
                int lane = lane_, r = r_, g = g_, c0 = c0_, c1 = c1_;
                asm volatile("" : "+v"(lane), "+v"(r), "+v"(g), "+v"(c0), "+v"(c1));
                const int b_nxt = (b_cur == 2) ? 0 : b_cur + 1;
                if (t + 1 < NT) AT_LOAD(t + 1);
                const LAS unsigned char* kb = lds + b_cur * AT_BUF; const LAS unsigned char* vb = kb + AT_KB;
                f32x4 s[4][2];
                AT_QK(kb);
                AT_SM1(0); AT_SM1(1);
                AT_PV(vb);
                if (t + 1 < NT) AT_STORE(b_nxt);
                __syncthreads();
                b_cur = b_nxt;
            }
        } else {
            int b_cur = 0, b_prev = 2;
            for (int t = 0; t < NT; ++t) {
                int lane = lane_, r = r_, g = g_, c0 = c0_, c1 = c1_;
                asm volatile("" : "+v"(lane), "+v"(r), "+v"(g), "+v"(c0), "+v"(c1));
                const int b_nxt = (b_cur == 2) ? 0 : b_cur + 1;
                const LAS unsigned char* kb = lds + b_cur * AT_BUF; const LAS unsigned char* vbp = lds + b_prev * AT_BUF + AT_KB;
                if (t > 0) AT_PV(vbp);
                asm volatile("" ::: "memory");
                if (t + 1 < NT) AT_LOAD(t + 1);
                f32x4 s[4][2];
                AT_QK(kb);
                AT_SM1(0); AT_SM1(1);
                if (t + 1 < NT) AT_STORE(b_nxt);
                __syncthreads();
                b_prev = b_cur; b_cur = b_nxt;
            }
            { int lane = lane_; asm volatile("" : "+v"(lane)); const LAS unsigned char* vbp = lds + b_prev * AT_BUF + AT_KB; AT_PV(vbp); }
        }
#undef AT_LOAD
#undef AT_STORE
#undef AT_QK
#undef AT_SM1
#undef AT_PV
        int re = tid & 15, ge = (tid & 63) >> 4; asm volatile("" : "+v"(re), "+v"(ge));
#pragma unroll
        for (int qt = 0; qt < 2; ++qt) {
            float l = lrow[qt]; l = sum_x16(l); l = sum_x32(l); const float inv = 1.f / l;
            unsigned char* op = (unsigned char*)O + (rowbase + qb * 256 + wid * 32 + 16 * qt + re) * 1024 + h * 128 + 4 * ge;
            const float inv8 = inv * O8_SCALE;
#pragma unroll
            for (int dt = 0; dt < 8; ++dt) *(unsigned*)(op + 16 * dt) = pk4_fp8(o[dt][qt][0] * inv8, o[dt][qt][1] * inv8, o[dt][qt][2] * inv8, o[dt][qt][3] * inv8);
        }
    }
}

constexpr int RT_KS = 528, RT_VS = 144, RT_K = 0, RT_V = 128 * RT_KS, RT_VD = RT_V + 128 * RT_VS, RT_ST = RT_VD + 128 * RT_VS, RT_END = RT_ST + 64 * RT_KS;
static_assert(RT_END <= LDS_BYTES, "retention LDS");
__device__ __forceinline__ void ret_phase(LAS unsigned char* lds, const bf16_t* Qr, const bf16_t* Kr, const bf16_t* Vr, bf16_t* Yr, const float* decay_logit, int bid, int G, const int tid0) {
    const int lane0 = tid0 & 63, wid = __builtin_amdgcn_readfirstlane(tid0 >> 6), r0 = lane0 & 15, g0 = lane0 >> 4;
    constexpr float LOG2E = 1.4426950408889634f;
    const int vcu = (G % 8 == 0) ? (bid % 8) * (G / 8) + bid / 8 : bid;
    for (int it = vcu; it < NB * 4 * 8; it += G) {
        const int b = it >> 5, h = (it >> 3) & 3, db = it & 7; const size_t rowbase = (size_t)b * SEQ;
        const float lgf = logsigmoid_f(decay_logit[h]) * LOG2E, lgb = logsigmoid_f(decay_logit[4 + h]) * LOG2E;
        for (int sweep = 0; sweep < 2; ++sweep) {
            const float lg = sweep ? lgf : lgb;
            f32x4 S[2][4];
#pragma unroll
            for (int a2 = 0; a2 < 2; ++a2)
#pragma unroll
                for (int dt = 0; dt < 4; ++dt) S[a2][dt] = (f32x4){0.f, 0.f, 0.f, 0.f};
            __syncthreads();
            for (int c = tid0; c < 64 * RT_KS / 16; c += NTHREADS) *(LAS u32x4*)(lds + RT_ST + c * 16) = (u32x4){0u, 0u, 0u, 0u};
            u32x4 rk[8], rv[2];
            const bf16_t* gk = Kr + rowbase * 1024 + h * 256; const bf16_t* gv = Vr + rowbase * 2048 + h * 512 + db * 64;
#define RT_LOAD(c) do { const size_t t0_ = (size_t)(c) * 128; \
                _Pragma("unroll") for (int i_ = 0; i_ < 8; ++i_) { const int ch_ = tid + 512 * i_; rk[i_] = *(const u32x4*)(gk + (t0_ + (ch_ >> 5)) * 1024 + (ch_ & 31) * 8); } \
                _Pragma("unroll") for (int i_ = 0; i_ < 2; ++i_) { const int ch_ = tid + 512 * i_; rv[i_] = *(const u32x4*)(gv + (t0_ + (ch_ >> 3)) * 2048 + (ch_ & 7) * 8); } } while (0)
            bf16x8 qn[8];
#define RT_LOADQ(c) do { const bf16_t* qp_ = Qr + (rowbase + (size_t)(c) * 128 + wid * 16 + r) * 1024 + h * 256 + 8 * g; \
                _Pragma("unroll") for (int ks_ = 0; ks_ < 8; ++ks_) qn[ks_] = *(const bf16x8*)(qp_ + 32 * ks_); } while (0)
            { const int tid = tid0, r = r0, g = g0; RT_LOAD(sweep ? 0 : 31); RT_LOADQ(sweep ? 0 : 31); }
            for (int step = 0; step < 32; ++step) {
                const int c = sweep ? step : 31 - step;
                int tid = tid0, lane = lane0, r = r0, g = g0;
                asm volatile("" : "+v"(tid), "+v"(lane), "+v"(r), "+v"(g));
                __syncthreads();
#pragma unroll
                for (int a2 = 0; a2 < 2; ++a2)
#pragma unroll
                    for (int dt = 0; dt < 4; ++dt) { u32x2 w; w.x = pk2(S[a2][dt][0], S[a2][dt][1]); w.y = pk2(S[a2][dt][2], S[a2][dt][3]);
                        *(LAS u32x2*)(lds + RT_ST + (16 * dt + r) * RT_KS + (16 * (2 * wid + a2) + 4 * g) * 2) = w; }
#pragma unroll
                for (int i = 0; i < 8; ++i) { const int ch = tid + 512 * i; *(LAS u32x4*)(lds + RT_K + (ch >> 5) * RT_KS + (ch & 31) * 16) = rk[i]; }
#pragma unroll
                for (int i = 0; i < 2; ++i) { const int ch = tid + 512 * i, j = ch >> 3; *(LAS u32x4*)(lds + RT_V + j * RT_VS + (ch & 7) * 16) = rv[i];
                    const float kd = fexp2((sweep ? (float)(127 - j) : (float)j) * lg);
                    u32x4 w; w.x = pk2(bf_lo(rv[i].x) * kd, bf_hi(rv[i].x) * kd); w.y = pk2(bf_lo(rv[i].y) * kd, bf_hi(rv[i].y) * kd); w.z = pk2(bf_lo(rv[i].z) * kd, bf_hi(rv[i].z) * kd); w.w = pk2(bf_lo(rv[i].w) * kd, bf_hi(rv[i].w) * kd);
                    *(LAS u32x4*)(lds + RT_VD + j * RT_VS + (ch & 7) * 16) = w; }
                bf16x8 qf[8];
#pragma unroll
                for (int ks = 0; ks < 8; ++ks) qf[ks] = qn[ks];
                u32x2 ypart[4];
                if (sweep) { const bf16_t* ypl = Yr + (rowbase + (size_t)c * 128 + wid * 16 + r) * 2048 + h * 512 + db * 64 + 4 * g;
#pragma unroll
                    for (int dt = 0; dt < 4; ++dt) ypart[dt] = *(const u32x2*)(ypl + 16 * dt); }
                __syncthreads();
                const int il = wid * 16 + r;
                f32x4 acc[4];
#pragma unroll
                for (int dt = 0; dt < 4; ++dt) acc[dt] = (f32x4){0.f, 0.f, 0.f, 0.f};
#pragma unroll
                for (int ks = 0; ks < 8; ++ks)
#pragma unroll
                    for (int dt = 0; dt < 4; ++dt) { const bf16x8 sf = *(const LAS bf16x8*)(lds + RT_ST + (16 * dt + r) * RT_KS + (32 * ks + 8 * g) * 2); acc[dt] = mfma16(sf, qf[ks], acc[dt]); }
                { const float qd = fexp2((sweep ? (float)(il + 1) : (float)(128 - il)) * lg);
#pragma unroll
                  for (int dt = 0; dt < 4; ++dt) acc[dt] = acc[dt] * qd; }
                if (sweep) {
#pragma unroll
                    for (int hf = 0; hf < 2; ++hf) {
                        f32x4 sc[4];
#pragma unroll
                        for (int j4 = 0; j4 < 4; ++j4) { const int jt = 4 * hf + j4; sc[j4] = (f32x4){0.f, 0.f, 0.f, 0.f};
#pragma unroll
                            for (int ks = 0; ks < 8; ++ks) { const bf16x8 kf = *(const LAS bf16x8*)(lds + RT_K + (16 * jt + r) * RT_KS + (32 * ks + 8 * g) * 2); sc[j4] = mfma16(kf, qf[ks], sc[j4]); }
#pragma unroll
                            for (int jj = 0; jj < 4; ++jj) { const int d = il - (16 * jt + 4 * g + jj); sc[j4][jj] *= (d >= 0) ? fexp2((float)d * lgf) : fexp2((float)(-d) * lgb); }
                            asm volatile("" ::: "memory"); }
#pragma unroll
                        for (int k2 = 0; k2 < 2; ++k2) { const bf16x8 pf = pack_frag(sc[2 * k2], sc[2 * k2 + 1]);
#pragma unroll
                            for (int dt = 0; dt < 4; ++dt) { const bf16x8 vf = tr_frag(lds + RT_V, RT_VS, 32 * (2 * hf + k2), 16 * dt, lane); acc[dt] = mfma16(vf, pf, acc[dt]); } }
                        asm volatile("" ::: "memory");
                    }
                }
                { bf16_t* yp = Yr + (rowbase + (size_t)c * 128 + il) * 2048 + h * 512 + db * 64 + 4 * g;
#pragma unroll
                  for (int dt = 0; dt < 4; ++dt) { f32x4 v = acc[dt];
                      if (sweep) { const u32x2 pw = ypart[dt]; v[0] += bf_lo(pw.x); v[1] += bf_hi(pw.x); v[2] += bf_lo(pw.y); v[3] += bf_hi(pw.y); }
                      u32x2 w; w.x = pk2(v[0], v[1]); w.y = pk2(v[2], v[3]); *(u32x2*)(yp + 16 * dt) = w; } }
                if (step + 1 < 32) { RT_LOAD(sweep ? step + 1 : 30 - step); RT_LOADQ(sweep ? step + 1 : 30 - step); }
                { const float gc = fexp2(128.f * lg);
#pragma unroll
                  for (int a2 = 0; a2 < 2; ++a2)
#pragma unroll
                      for (int dt = 0; dt < 4; ++dt) S[a2][dt] = S[a2][dt] * gc; }
#pragma unroll
                for (int k2 = 0; k2 < 4; ++k2) {
                    bf16x8 vd[4];
#pragma unroll
                    for (int dt = 0; dt < 4; ++dt) vd[dt] = tr_frag(lds + RT_VD, RT_VS, 32 * k2, 16 * dt, lane);
#pragma unroll
                    for (int a2 = 0; a2 < 2; ++a2) { const bf16x8 kt = tr_frag(lds + RT_K, RT_KS, 32 * k2, 16 * (2 * wid + a2), lane);
#pragma unroll
                        for (int dt = 0; dt < 4; ++dt) S[a2][dt] = mfma16(kt, vd[dt], S[a2][dt]); }
                }
            }
#undef RT_LOAD
#undef RT_LOADQ
        }
        __syncthreads();
    }
}

constexpr int GP_LR = 0, GP_TOT = 8192, GP_END = 8192 + 4096;
__device__ __forceinline__ void gla_pre_phase(LAS unsigned char* lds, bf16_t* Qg, bf16_t* Kg, const float* LR, const float* w_a2, const float* b_a, bf16_t* QB, bf16_t* KB, float* ET, int bid, int G, const int tid) {
    const int vcu = (G % 8 == 0) ? (bid % 8) * (G / 8) + bid / 8 : bid;
    const int d = tid & 127, ig = tid >> 7;
    LAS float* lrs = (LAS float*)(lds + GP_LR); LAS float* tot = (LAS float*)(lds + GP_TOT);
    for (int it = vcu; it < NB * 4 * 64; it += G) {
        const int b = it >> 8, h = (it >> 6) & 3, c = it & 63; const size_t tok0 = (size_t)b * SEQ + (size_t)c * 64;
        float qv[16], kv[16];
#pragma unroll
        for (int tt = 0; tt < 16; ++tt) { const size_t o = (tok0 + 16 * ig + tt) * 512 + h * 128 + d; qv[tt] = bf2f(Qg[o]); kv[tt] = bf2f(Kg[o]); }
        *(LAS f32x4*)(lrs + (tid >> 3) * 32 + (tid & 7) * 4) = *(const f32x4*)(LR + (tok0 + (tid >> 3)) * 32 + (tid & 7) * 4);
        __syncthreads();
        float bl0[16], bl1[16];
        {
            float w2r[16];
#pragma unroll
            for (int rr = 0; rr < 16; ++rr) w2r[rr] = w_a2[(size_t)rr * 512 + h * 128 + d];
            const float ba = b_a[h * 128 + d]; float run = 0.f;
#pragma unroll
            for (int tt = 0; tt < 16; ++tt) { const LAS float* lp = lrs + (16 * ig + tt) * 32; float a = ba;
#pragma unroll
                for (int q4 = 0; q4 < 4; ++q4) { const f32x4 lv = *(const LAS f32x4*)(lp + 4 * q4); a += lv[0] * w2r[4 * q4] + lv[1] * w2r[4 * q4 + 1] + lv[2] * w2r[4 * q4 + 2] + lv[3] * w2r[4 * q4 + 3]; }
                run += logsigmoid_f(a) * 0.0625f; bl0[tt] = run; }
            tot[ig * 128 + d] = run;
        }
        {
            float w2r[16];
#pragma unroll
            for (int rr = 0; rr < 16; ++rr) w2r[rr] = w_a2[((size_t)16 + rr) * 512 + h * 128 + d];
            const float ba = b_a[512 + h * 128 + d];
#pragma unroll
            for (int tt = 0; tt < 16; ++tt) { const LAS float* lp = lrs + (16 * ig + tt) * 32 + 16; float a = ba;
#pragma unroll
                for (int q4 = 0; q4 < 4; ++q4) { const f32x4 lv = *(const LAS f32x4*)(lp + 4 * q4); a += lv[0] * w2r[4 * q4] + lv[1] * w2r[4 * q4 + 1] + lv[2] * w2r[4 * q4 + 2] + lv[3] * w2r[4 * q4 + 3]; }
                bl1[tt] = logsigmoid_f(a) * 0.0625f; }
            float run = 0.f;
#pragma unroll
            for (int tt = 15; tt >= 0; --tt) { run += bl1[tt]; bl1[tt] = run; }
            tot[512 + ig * 128 + d] = run;
        }
        __syncthreads();
        float off0 = 0.f, tot0 = 0.f, off1 = 0.f, tot1 = 0.f;
#pragma unroll
        for (int g2 = 0; g2 < 4; ++g2) { const float t0 = tot[g2 * 128 + d], t1 = tot[512 + g2 * 128 + d]; tot0 += t0; tot1 += t1; if (g2 < ig) off0 += t0; if (g2 > ig) off1 += t1; }
#pragma unroll
        for (int tt = 0; tt < 16; ++tt) { const size_t o = (tok0 + 16 * ig + tt) * 512 + h * 128 + d; const float b0 = bl0[tt] + off0, b1 = bl1[tt] + off1;
            Qg[o] = f2bf(qv[tt] * __expf(b0)); Kg[o] = f2bf(kv[tt] * __expf(-b0));
            QB[o] = f2bf(qv[tt] * __expf(b1)); KB[o] = f2bf(kv[tt] * __expf(-b1)); }
        if (ig == 0) { const size_t eo = ((size_t)b * 64 + c) * 512 + h * 128 + d; ET[eo] = __expf(tot0); ET[(size_t)NB * 64 * 512 + eo] = __expf(tot1); }
        __syncthreads();
    }
}
constexpr int GL_S = 272, GL_VS = 144;
constexpr int GL_QIN = 0, GL_KIN = 64 * GL_S, GL_KST = 2 * 64 * GL_S, GL_V = 3 * 64 * GL_S, GL_EBL = GL_V + 64 * GL_VS, GL_ST = GL_EBL + 512, GL_END = GL_ST + 2 * 64 * GL_S;
static_assert(GL_END <= LDS_BYTES - 64, "gla LDS");
__device__ __forceinline__ void gla_phase(LAS unsigned char* lds, const bf16_t* Qf, const bf16_t* Kf, const bf16_t* QB, const bf16_t* KB, const bf16_t* Vg, const float* ET, bf16_t* Yf, bf16_t* Yb, int bid, int G, const int tid0) {
    const int lane0 = tid0 & 63, wid = __builtin_amdgcn_readfirstlane(tid0 >> 6);
    const int vcu = (G % 8 == 0) ? (bid % 8) * (G / 8) + bid / 8 : bid;
    for (int it = vcu; it < NB * 4 * 2 * 4; it += G) {
        const int b = it >> 5, h = (it >> 3) & 3, fwd = (it >> 2) & 1, db = it & 3; const size_t rowbase = (size_t)b * SEQ;
        const bf16_t* QI = fwd ? Qf : QB; const bf16_t* KI = fwd ? Kf : KB; const float* ETz = ET + (fwd ? 0 : (size_t)NB * 64 * 512) + (size_t)b * 64 * 512 + h * 128; bf16_t* Yo = fwd ? Yf : Yb;
        f32x4 S[4];
#pragma unroll
        for (int dt = 0; dt < 4; ++dt) S[dt] = (f32x4){0.f, 0.f, 0.f, 0.f};
        __syncthreads();
        for (int c = tid0; c < 64 * GL_S / 16; c += NTHREADS) *(LAS u32x4*)(lds + GL_ST + c * 16) = (u32x4){0u, 0u, 0u, 0u};
        u32x4 rq[2], rkk[2], rvv; f32x4 re0, re1;
#define GL_LOAD(c) do { const size_t t0_ = rowbase + (size_t)(c) * 64; \
            _Pragma("unroll") for (int i_ = 0; i_ < 2; ++i_) { const int ch_ = tid + 512 * i_; const size_t o_ = (t0_ + (ch_ >> 4)) * 512 + h * 128 + (ch_ & 15) * 8; rq[i_] = *(const u32x4*)(QI + o_); rkk[i_] = *(const u32x4*)(KI + o_); } \
            rvv = *(const u32x4*)(Vg + (t0_ + (tid >> 3)) * 1024 + h * 256 + db * 64 + (tid & 7) * 8); \
            { const float* ep_ = ETz + (size_t)(c) * 512 + (tid & 15) * 8; re0 = *(const f32x4*)ep_; re1 = *(const f32x4*)(ep_ + 4); } } while (0)
        { const int tid = tid0; GL_LOAD(fwd ? 0 : 63); }
        for (int step = 0; step < 64; ++step) {
            const int c = fwd ? step : 63 - step; const size_t tok0 = rowbase + (size_t)c * 64;
            int tid = tid0, lane = lane0; asm volatile("" : "+v"(tid), "+v"(lane));
            const int r = lane & 15, g = lane >> 4;
            const LAS unsigned char* stc = lds + GL_ST + (step & 1) * 64 * GL_S; LAS unsigned char* stn = lds + GL_ST + ((step + 1) & 1) * 64 * GL_S;
            const LAS unsigned char* vs = lds + GL_V;
            __syncthreads();
#pragma unroll
            for (int i = 0; i < 2; ++i) { const int ch = tid + 512 * i, row = ch >> 4, cc = ch & 15;
                *(LAS u32x4*)(lds + GL_QIN + row * GL_S + cc * 16) = rq[i]; *(LAS u32x4*)(lds + GL_KIN + row * GL_S + cc * 16) = rkk[i];
                u32x4 w; w.x = pk2(bf_lo(rkk[i].x) * re0[0], bf_hi(rkk[i].x) * re0[1]); w.y = pk2(bf_lo(rkk[i].y) * re0[2], bf_hi(rkk[i].y) * re0[3]);
                w.z = pk2(bf_lo(rkk[i].z) * re1[0], bf_hi(rkk[i].z) * re1[1]); w.w = pk2(bf_lo(rkk[i].w) * re1[2], bf_hi(rkk[i].w) * re1[3]);
                *(LAS u32x4*)(lds + GL_KST + row * GL_S + cc * 16) = w; }
            *(LAS u32x4*)(lds + GL_V + (tid >> 3) * GL_VS + (tid & 7) * 16) = rvv;
            if (tid < 16) { LAS float* ebl = (LAS float*)(lds + GL_EBL) + tid * 8; *(LAS f32x4*)ebl = re0; *(LAS f32x4*)(ebl + 4) = re1; }
            __syncthreads();
            if (step + 1 < 64) GL_LOAD(fwd ? step + 1 : 62 - step);
            const int it4 = wid & 3, dh = wid >> 2, il = 16 * it4 + r;
            bf16x8 qf[4];
#pragma unroll
            for (int ks = 0; ks < 4; ++ks) qf[ks] = *(const LAS bf16x8*)(lds + GL_QIN + il * GL_S + (32 * ks + 8 * g) * 2);
            f32x4 acc[2]; acc[0] = (f32x4){0.f, 0.f, 0.f, 0.f}; acc[1] = (f32x4){0.f, 0.f, 0.f, 0.f};
#pragma unroll
            for (int ks = 0; ks < 4; ++ks)
#pragma unroll
                for (int dd = 0; dd < 2; ++dd) { const bf16x8 sf = *(const LAS bf16x8*)(stc + (16 * (2 * dh + dd) + r) * GL_S + (32 * ks + 8 * g) * 2); acc[dd] = mfma16(sf, qf[ks], acc[dd]); }
            f32x4 sc[4];
#pragma unroll
            for (int jt = 0; jt < 4; ++jt) { sc[jt] = (f32x4){0.f, 0.f, 0.f, 0.f};
#pragma unroll
                for (int ks = 0; ks < 4; ++ks) { const bf16x8 kf = *(const LAS bf16x8*)(lds + GL_KIN + (16 * jt + r) * GL_S + (32 * ks + 8 * g) * 2); sc[jt] = mfma16(kf, qf[ks], sc[jt]); }
#pragma unroll
                for (int jj = 0; jj < 4; ++jj) { const int j = 16 * jt + 4 * g + jj; const bool keep = fwd ? (j <= il) : (j > il); if (!keep) sc[jt][jj] = 0.f; } }
#pragma unroll
            for (int k2 = 0; k2 < 2; ++k2) { const bf16x8 pf = pack_frag(sc[2 * k2], sc[2 * k2 + 1]);
#pragma unroll
                for (int dd = 0; dd < 2; ++dd) { const bf16x8 vf = tr_frag(vs, GL_VS, 32 * k2, 16 * (2 * dh + dd), lane); acc[dd] = mfma16(vf, pf, acc[dd]); } }
            { bf16_t* yp = Yo + (tok0 + il) * 1024 + h * 256 + db * 64 + 32 * dh + 4 * g;
#pragma unroll
              for (int dd = 0; dd < 2; ++dd) { u32x2 w; w.x = pk2(acc[dd][0], acc[dd][1]); w.y = pk2(acc[dd][2], acc[dd][3]); *(u32x2*)(yp + 16 * dd) = w; } }
            { const LAS float* ebl = (const LAS float*)(lds + GL_EBL);
#pragma unroll
              for (int jj = 0; jj < 4; ++jj) { const float e = ebl[16 * wid + 4 * g + jj];
#pragma unroll
                  for (int dt = 0; dt < 4; ++dt) S[dt][jj] *= e; } }
#pragma unroll
            for (int k2 = 0; k2 < 2; ++k2) { const bf16x8 kt = tr_frag(lds + GL_KST, GL_S, 32 * k2, 16 * wid, lane);
#pragma unroll
                for (int dt = 0; dt < 4; ++dt) { const bf16x8 vf = tr_frag(vs, GL_VS, 32 * k2, 16 * dt, lane); S[dt] = mfma16(kt, vf, S[dt]); } }
#pragma unroll
            for (int dt = 0; dt < 4; ++dt) { u32x2 w; w.x = pk2(S[dt][0], S[dt][1]); w.y = pk2(S[dt][2], S[dt][3]); *(LAS u32x2*)(stn + (16 * dt + r) * GL_S + (16 * wid + 4 * g) * 2) = w; }
        }
#undef GL_LOAD
        __syncthreads();
    }
}

#define XB_TMO      128
#define XB_XCNT(j)  (256  + 64 * (j))
#define XB_XSUB(j)  (1280 + 64 * (j))
#define XB_XGEN(j)  (2304 + 64 * (j))
#define XB_TOP      3328
#define XB_TOPGEN   3392
#define XCD_BAR_WORDS 3456
#define XB_SPIN_CAP (1u << 18)

__device__ __forceinline__ unsigned xb_ld(unsigned* p)              { return __hip_atomic_load(p, __ATOMIC_RELAXED, __HIP_MEMORY_SCOPE_AGENT); }
__device__ __forceinline__ unsigned xb_add(unsigned* p, unsigned v) { return __hip_atomic_fetch_add(p, v, __ATOMIC_RELAXED, __HIP_MEMORY_SCOPE_AGENT); }
__device__ __forceinline__ unsigned xb_xcc_id() { return (unsigned)__builtin_amdgcn_s_getreg((3 << 11) | 20) & 0xFu; }
#define XB_SPIN(cond, bar) do { unsigned _sp = 0; while (cond) { __builtin_amdgcn_s_sleep(1); \
    if ((++_sp & 255u) == 0u) { if (xb_ld(&(bar)[XB_TMO])) break; if (_sp > XB_SPIN_CAP) { atomicAdd(&(bar)[XB_TMO], 1u); break; } } } } while (0)

struct XcdBarrier {
    unsigned* bar; unsigned x;
    volatile LAS unsigned* st;
};

__device__ __forceinline__ XcdBarrier xcd_barrier_post(unsigned* bar, volatile LAS unsigned* st) {
    XcdBarrier b; b.bar = bar; b.x = xb_xcc_id(); b.st = st;
    if (threadIdx.x == 0) (void)xb_add(&bar[XB_XCNT(b.x)], 1u);
    return b;
}
__device__ __forceinline__ void xcd_barrier_complete(unsigned* bar, unsigned x, unsigned& nloc, unsigned& nx) {
    const unsigned G = gridDim.x * gridDim.y * gridDim.z;
    unsigned sum, cnt, mine, sp = 0u;
    for (;;) {
        sum = 0u; cnt = 0u; mine = 0u;
#pragma unroll
        for (unsigned j = 0; j < 16; ++j) { const unsigned c = xb_ld(&bar[XB_XCNT(j)]); sum += c; cnt += (c > 0u) ? 1u : 0u; mine = (j == x) ? c : mine; }
        if (sum == G) break;
        __builtin_amdgcn_s_sleep(1);
        if ((++sp & 255u) == 0u) { if (xb_ld(&bar[XB_TMO])) break; if (sp > XB_SPIN_CAP) { atomicAdd(&bar[XB_TMO], 1u); break; } }
    }
    nloc = mine > 0u ? mine : 1u; nx = cnt > 0u ? cnt : 1u;
}

__device__ __forceinline__ void xcd_barrier(const XcdBarrier& b) {
    asm volatile("s_waitcnt vmcnt(0)" ::: "memory");
    __syncthreads();
    if (threadIdx.x == 0) {
        unsigned* bar = b.bar;
        __builtin_amdgcn_s_waitcnt(0);
        unsigned nloc = b.st[0], nx = b.st[1];
        if (nloc == 0u) { xcd_barrier_complete(bar, b.x, nloc, nx); b.st[0] = nloc; b.st[1] = nx; }
        const unsigned old = xb_add(&bar[XB_XSUB(b.x)], 1u);
        const unsigned gen = old / nloc;
        if (old + 1u == (gen + 1u) * nloc) {
            __builtin_amdgcn_fence(__ATOMIC_RELEASE, "agent");
            asm volatile("s_waitcnt vmcnt(0)" ::: "memory");
            const unsigned og = xb_add(&bar[XB_TOP], 1u);
            const unsigned tg = og / nx;
            if (og + 1u == (tg + 1u) * nx) xb_add(&bar[XB_TOPGEN], 1u);
            else XB_SPIN(xb_ld(&bar[XB_TOPGEN]) == tg, bar);
            __builtin_amdgcn_fence(__ATOMIC_ACQUIRE, "agent");
            xb_add(&bar[XB_XGEN(b.x)], 1u);
            asm volatile("s_waitcnt vmcnt(0)" ::: "memory");
        } else {
            XB_SPIN(xb_ld(&bar[XB_XGEN(b.x)]) == gen, bar);
            __builtin_amdgcn_fence(__ATOMIC_ACQUIRE, "agent");
            asm volatile("s_waitcnt vmcnt(0)" ::: "memory");
        }
    }
    __syncthreads();
}

constexpr size_t WS_BAR = 0, WS_BAR_BYTES = 65536;
constexpr int LDS_BARST = LDS_BYTES - 64;
#ifndef N_LAUNCH_PER_PHASE
#define N_LAUNCH_PER_PHASE 0
#endif
#ifndef DBG_RET
#define DBG_RET 0
#endif
#ifndef DBG_NOMIX
#define DBG_NOMIX 0
#endif
#ifndef OPMASK
#define OPMASK 0xFFF
#endif
enum { OP_PRO, OP_DOWN, OP_UQ, OP_SG, OP_ATTN, OP_LN, OP_FFNIN, OP_RETQKV, OP_RETCORE, OP_RETGATE, OP_GLACORE, OP_GLAGATE, OP_GLAPRE };
enum { SG_UKV, SG_MLAWO, SG_FFNOUT, SG_RETG, SG_RETWO, SG_GLAIN, SG_GLAWO };
struct Ph { unsigned char op, sub, layer, sync; };
#define MLA_LAYER(L) {OP_DOWN, 0, L, 1}, {OP_UQ, 0, L, 0}, {OP_SG, SG_UKV, L, 1}, {OP_ATTN, 0, L, 1}, {OP_SG, SG_MLAWO, L, 1}
#define FFN_PART(L) {OP_LN, 0, L, 1}, {OP_FFNIN, 0, L, 1}, {OP_SG, SG_FFNOUT, L, 1}, {OP_LN, 1, L, 1}
__device__ const Ph PHASES[] = {
    {OP_PRO, 0, 0, 1},
    MLA_LAYER(0), FFN_PART(0),
    {OP_RETQKV, 0, 1, 1}, {OP_RETCORE, 0, 1, 1}, {OP_SG, SG_RETG, 1, 1}, {OP_RETGATE, 0, 1, 1}, {OP_SG, SG_RETWO, 1, 1}, FFN_PART(1),
    {OP_SG, SG_GLAIN, 2, 1}, {OP_GLAPRE, 0, 2, 1}, {OP_GLACORE, 0, 2, 1}, {OP_GLAGATE, 0, 2, 1}, {OP_SG, SG_GLAWO, 2, 1}, FFN_PART(2),
    MLA_LAYER(3), FFN_PART(3),
};
constexpr int N_PHASES = 1 + 9 + 9 + 9 + 9;

__global__ void __launch_bounds__(NTHREADS, 2) fwd_kernel(Args args) {
#if defined(__HIP_DEVICE_COMPILE__)
    extern __shared__ __attribute__((aligned(16))) unsigned char lds_raw[];
    LAS unsigned char* lds = (LAS unsigned char*)lds_raw;
    cg::grid_group grid = cg::this_grid();
    const int ph_lo = args.ph_lo, ph_hi = args.ph_hi;
    const int wave0 = __builtin_amdgcn_readfirstlane((int)threadIdx.x >> 6);
#if !N_LAUNCH_PER_PHASE
    if (threadIdx.x < 2) ((volatile LAS unsigned*)(lds + LDS_BARST))[threadIdx.x] = 0u;
    __syncthreads();
    (void)xcd_barrier_post((unsigned*)(args.ws + WS_BAR), (volatile LAS unsigned*)(lds + LDS_BARST));
#endif
    for (int ph = ph_lo; ph < ph_hi; ++ph) {
        KArgs ap = (KArgs)__builtin_amdgcn_kernarg_segment_ptr();
        asm volatile("" : "+s"(ap));
        int wv = wave0, G = gridDim.x, bid = blockIdx.x; asm volatile("" : "+s"(wv), "+s"(G), "+s"(bid));
        unsigned char* ws = ap->ws; float* out = ap->out;
        const int wid = wv;
        const int gw = bid * NWAVES + wid, ngw = G * NWAVES;
        bf16_t* XB = (bf16_t*)(ws + WS_XB); bf16_t* Y = (bf16_t*)(ws + A_Y);
        const f32x2* tabM = (const f32x2*)(ws + WS_TABM); const f32x2* tabR = (const f32x2*)(ws + WS_TABR);
        const Ph P = PHASES[ph]; const int L = P.layer, kind = L % 3, j = L / 3;
        switch (P.op) {
#if OPMASK & (1 << 0)
        case OP_PRO: {
            const int tid = phase_tid(wv), lane = tid & 63; (void)lane;
            Cvt C{(LAS float*)(lds + wid * 8448), gw, ngw, lane, 0};
            convert_layer(C, ap, ws, 0);
            for (int row = gw; row < T; row += ngw) {
#pragma unroll
                for (int q = 0; q < 4; ++q) { const f32x4 v = *(const f32x4*)(ap->in.x + (size_t)row * DM + 4 * lane + 256 * q); *(unsigned*)((unsigned char*)XB + (size_t)row * DM + 4 * lane + 256 * q) = pk4_fp8(v[0] * X8_SCALE, v[1] * X8_SCALE, v[2] * X8_SCALE, v[3] * X8_SCALE); }
            }
            for (int e = bid * NTHREADS + tid; e < T * 32; e += G * NTHREADS) ((f32x2*)(ws + WS_TABM))[e] = rope_compute(ap->in.pos[e >> 5], e & 31, 32);
            for (int e = bid * NTHREADS + tid; e < 2 * T * 2; e += G * NTHREADS) ((float*)(ws + WS_SS))[e] = 0.f;
        } break;
#endif
#if OPMASK & (1 << 1)
        case OP_DOWN: {
            const int tid = phase_tid(wv), lane = tid & 63; (void)lane;
            pg8::Gemm gm{XB, (const bf16_t*)(ws + WS_WM + WM_MLA_DOWN), T, 1024, 512}; pg8::StaticOrder S; S.init(T, 1024, G, bid);
            EpiDown E{(bf16_t*)(ws + A_CQ), (bf16_t*)(ws + A_CKV), (bf16_t*)(ws + A_KR), (float*)(ws + WS_SS) + (size_t)j * T * 2, tabM, 1.f / (X8_SCALE * WD8_SCALE)};
            pg8::gemm_phase<EpiDown, pg8::StaticOrder, true, true, true>(lds, gm, S, E, tid);
        } break;
#endif
#if OPMASK & (1 << 2)
        case OP_UQ: {
            const int tid = phase_tid(wv), lane = tid & 63; (void)lane;
            pg8::Gemm gm{(const bf16_t*)(ws + A_CQ), (const bf16_t*)(ws + WS_WM + WM_MLA_UQ), T, 1536, 256}; pg8::StaticOrder S; S.init(T, 1536, G, bid);
            EpiUq E{(bf16_t*)(ws + A_Q), (const float*)(ws + WS_SS) + (size_t)j * T * 2, tabM, 0.07216878364870322f * 1.4426950408889634f / (C8_SCALE * WU8_SCALE)};
            pg8::gemm_phase<EpiUq, pg8::StaticOrder, true, true, true>(lds, gm, S, E, tid);
        } break;
#endif
#if OPMASK & (1 << 3)
        case OP_SG: {
            const int tid = phase_tid(wv), lane = tid & 63; (void)lane;
            pg8::Gemm gm{}; EpiStore E{}; E.nseg = 1; E.ss = nullptr; E.lr = nullptr; E.lr_pn = -1; E.ss_col = 0; E.ss_invk = 0.f;
            switch (P.sub) {
            case SG_UKV: gm = pg8::Gemm{(const bf16_t*)(ws + A_CKV), (const bf16_t*)(ws + WS_WM + WM_MLA_UKV), T, 2048, 128};
                E.s0 = Seg{(bf16_t*)(ws + A_KN), 1024, 0, 1.f / (C8_SCALE * WU8_SCALE)}; E.s1 = Seg{(bf16_t*)(ws + A_V), 1024, 4, 1.f / (C8_SCALE * WU8_SCALE)}; E.nseg = 2; E.ss = (const float*)(ws + WS_SS) + (size_t)j * T * 2; E.ss_col = 1; E.ss_invk = 1.f / 256.f; break;
            case SG_MLAWO: gm = pg8::Gemm{(const bf16_t*)(ws + A_O), (const bf16_t*)(ws + WS_WM + WM_MLA_WO), T, 1024, 512}; E.s0 = Seg{Y, 1024, 0, 1.f / (O8_SCALE * WO8_SCALE)}; break;
            case SG_FFNOUT: gm = pg8::Gemm{(const bf16_t*)(ws + A_H), (const bf16_t*)(ws + WS_WF + WF_OUT), T, 1024, FF / 2}; E.s0 = Seg{Y, 1024, 0, 1.f / (H8_SCALE * W8_SCALE)}; break;
            case SG_RETG: gm = pg8::Gemm{XB, (const bf16_t*)(ws + WS_WM + WM_RET_IN) + (size_t)4096 * 1024, T, 2048, 1024}; E.s0 = Seg{(bf16_t*)(ws + A_RG), 2048, 0, 1.f}; break;
            case SG_RETWO: gm = pg8::Gemm{(const bf16_t*)(ws + A_RA), (const bf16_t*)(ws + WS_WM + WM_RET_WO), T, 1024, 2048}; E.s0 = Seg{Y, 1024, 0, 1.f}; break;
            case SG_GLAIN: gm = pg8::Gemm{XB, (const bf16_t*)(ws + WS_WM + WM_GLA_IN), T, 3328, 1024};
                E.s0 = Seg{(bf16_t*)(ws + A_GQ), 512, 0, 0.08838834764831845f}; E.s1 = Seg{(bf16_t*)(ws + A_GK), 512, 2, 1.f}; E.s2 = Seg{(bf16_t*)(ws + A_GV), 1024, 4, 1.f}; E.s3 = Seg{(bf16_t*)(ws + A_GR), 1024, 8, 1.f}; E.nseg = 4;
                E.lr = (float*)(ws + A_GLR); E.lr_pn = 12; break;
            default: gm = pg8::Gemm{(const bf16_t*)(ws + A_GA), (const bf16_t*)(ws + WS_WM + WM_GLA_WO), T, 1024, 1024}; E.s0 = Seg{Y, 1024, 0, 1.f}; break;
            }
            pg8::StaticOrder S; S.init(T, gm.N, G, bid);
            if (P.sub == SG_FFNOUT || P.sub == SG_MLAWO || P.sub == SG_UKV) pg8::gemm_phase<EpiStore, pg8::StaticOrder, true, true, true>(lds, gm, S, E, tid);
            else pg8::gemm_phase<EpiStore, pg8::StaticOrder, true, true>(lds, gm, S, E, tid);
        } break;
#endif
#if OPMASK & (1 << 4)
        case OP_ATTN: {
            const int tid = phase_tid(wv), lane = tid & 63; (void)lane; (void)tid;
            attn_phase(lds, (const bf16_t*)(ws + A_Q), (const bf16_t*)(ws + A_KN), (const bf16_t*)(ws + A_KR), (const bf16_t*)(ws + A_V), (bf16_t*)(ws + A_O), bid, G, tid);
        } break;
#endif
#if OPMASK & (1 << 5)
        case OP_LN: {
            const int tid = phase_tid(wv), lane = tid & 63; (void)lane;
            const bool first = (L == 0 && P.sub == 0), last = (L + 1 == DEPTH && P.sub == 1), prelast = (L + 1 == DEPTH && P.sub == 0);
            const void* lin = first ? (const void*)ap->in.x : last ? (const void*)(ws + A_XH) : (const void*)out; void* lout = prelast ? (void*)(ws + A_XH) : (void*)out;
            ln_phase(lin, !first, Y, ap->in.ln_g + (size_t)(L * 2 + P.sub) * DM, ap->in.ln_b + (size_t)(L * 2 + P.sub) * DM, lout, !last, XB, gw, ngw, lane, ((DBG_NOMIX >> (P.sub ? 3 : kind)) & 1) ? 0.f : 1.f, P.sub == 0 || (L + 1) % 3 == 0, P.sub == 1 && L + 1 == DEPTH);
            if (P.sub == 1 && L + 1 < DEPTH) { Cvt C{(LAS float*)(lds + wid * 8448), gw, ngw, lane, 0}; convert_layer(C, ap, ws, L + 1);
                if ((L + 1) % 3 == 1) for (int e = bid * NTHREADS + tid; e < T * 128; e += G * NTHREADS) ((f32x2*)(ws + WS_TABR))[e] = rope_compute(ap->in.pos[e >> 7], e & 127, 128); }
        } break;
#endif
#if OPMASK & (1 << 6)
        case OP_FFNIN: {
            const int tid = phase_tid(wv), lane = tid & 63; (void)lane;
            pg8::Gemm gm{XB, (const bf16_t*)(ws + WS_WF + WF_IN), T, 2 * FF, 512}; pg8::StaticOrder S; S.init(T, 2 * FF, G, bid);
            EpiSwiglu E{(bf16_t*)(ws + A_H), 1.f / (X8_SCALE * W8IN_SCALE)};
            pg8::gemm_phase<EpiSwiglu, pg8::StaticOrder, true, true, true>(lds, gm, S, E, tid);
        } break;
#endif
#if OPMASK & (1 << 7)
        case OP_RETQKV: {
            const int tid = phase_tid(wv), lane = tid & 63; (void)lane;
            pg8::Gemm gm{XB, (const bf16_t*)(ws + WS_WM + WM_RET_IN), T, 4096, 1024}; pg8::StaticOrder S; S.init(T, 4096, G, bid);
            EpiRet E{(bf16_t*)(ws + A_RQ), (bf16_t*)(ws + A_RK), (bf16_t*)(ws + A_RV), tabR};
            pg8::gemm_phase<EpiRet, pg8::StaticOrder, true, true>(lds, gm, S, E, tid);
        } break;
#endif
#if OPMASK & (1 << 8)
        case OP_RETCORE: {
            const int tid = phase_tid(wv), lane = tid & 63; (void)lane; (void)tid;
            ret_phase(lds, (const bf16_t*)(ws + A_RQ), (const bf16_t*)(ws + A_RK), (const bf16_t*)(ws + A_RV), (bf16_t*)(ws + A_RY), ap->in.ret_decay + (size_t)j * 8, bid, G, tid);
        } break;
#endif
#if OPMASK & (1 << 9)
        case OP_RETGATE: {
            const int tid = phase_tid(wv), lane = tid & 63; (void)lane; (void)tid;
            ret_gate_phase((const bf16_t*)(ws + A_RY), (const bf16_t*)(ws + A_RG), ap->in.ret_gnw + (size_t)j * 2048, ap->in.ret_gnb + (size_t)j * 2048, (bf16_t*)(ws + A_RA), gw, ngw, lane);
        } break;
#endif
#if OPMASK & (1 << 10)
        case OP_GLACORE: {
            const int tid = phase_tid(wv), lane = tid & 63; (void)lane; (void)tid;
            gla_phase(lds, (const bf16_t*)(ws + A_GQ), (const bf16_t*)(ws + A_GK), (const bf16_t*)(ws + A_GQB), (const bf16_t*)(ws + A_GKB), (const bf16_t*)(ws + A_GV), (const float*)(ws + A_GET), (bf16_t*)(ws + A_GY), (bf16_t*)(ws + A_GY2), bid, G, tid);
        } break;
#endif
#if OPMASK & (1 << 11)
        case OP_GLAGATE: {
            const int tid = phase_tid(wv), lane = tid & 63; (void)lane; (void)tid;
            gla_gate_phase((const bf16_t*)(ws + A_GY), (const bf16_t*)(ws + A_GY2), (const bf16_t*)(ws + A_GR), ap->in.gla_norm + (size_t)j * 256, (bf16_t*)(ws + A_GA), gw, ngw, lane);
        } break;
#endif
        case OP_GLAPRE: {
            const int tid = phase_tid(wv);
            gla_pre_phase(lds, (bf16_t*)(ws + A_GQ), (bf16_t*)(ws + A_GK), (const float*)(ws + A_GLR), ap->in.gla_a2 + (size_t)j * 2 * 16 * 512, ap->in.gla_ba + (size_t)j * 2 * 512, (bf16_t*)(ws + A_GQB), (bf16_t*)(ws + A_GKB), (float*)(ws + A_GET), bid, G, tid);
        } break;
        }
        (void)kind;
        if (P.sync && ph + 1 < ph_hi) {
            if (ph == 0) grid.sync();
            else { XcdBarrier xb; xb.bar = (unsigned*)(ws + WS_BAR); xb.x = xb_xcc_id(); xb.st = (volatile LAS unsigned*)(lds + LDS_BARST); xcd_barrier(xb); }
        }
        else __syncthreads();
    }
#endif
}

extern "C" void kernel_launch(void* const* d_in, const int* in_sizes, int n_in, void* d_out, int out_size, void* d_ws, size_t ws_size, hipStream_t stream) {
    static int grid = 0;
    if (grid == 0) {
        if (n_in != 23 || out_size != T * DM || ws_size < WS_END) { fprintf(stderr, "kernel_launch: unexpected shapes (n_in %d, out %d, ws %zu); nothing launched\n", n_in, out_size, ws_size); grid = -1; return; }
        int dev = 0, cus = 0, per_cu = 0;
        hipGetDevice(&dev); hipDeviceGetAttribute(&cus, hipDeviceAttributeMultiprocessorCount, dev);
        if (hipFuncSetAttribute((const void*)fwd_kernel, hipFuncAttributeMaxDynamicSharedMemorySize, LDS_BYTES) != hipSuccess) { fprintf(stderr, "kernel_launch: hipFuncSetAttribute failed\n"); grid = -1; return; }
        if (hipOccupancyMaxActiveBlocksPerMultiprocessor(&per_cu, (const void*)fwd_kernel, NTHREADS, LDS_BYTES) != hipSuccess || per_cu < 1) { fprintf(stderr, "kernel_launch: occupancy query gives %d blocks per CU\n", per_cu); per_cu = 1; }
        (void)hipGetLastError();
        grid = cus * per_cu;
        fprintf(stderr, "kernel_launch: grid %d (%d CUs x %d)\n", grid, cus, per_cu);
    }
    if (grid < 0) return;
    Args a{};
    const void** ip = (const void**)&a.in;
    for (int i = 0; i < 23; ++i) ip[i] = d_in[i];
    a.out = (float*)d_out; a.ws = (unsigned char*)d_ws;
#if N_LAUNCH_PER_PHASE
    for (int ph = 0; ph < N_PHASES; ++ph) { a.ph_lo = ph; a.ph_hi = ph + 1; hipLaunchKernelGGL(fwd_kernel, dim3(grid), dim3(NTHREADS), LDS_BYTES, stream, a); }
#else
    if (hipMemsetAsync((char*)d_ws + WS_BAR, 0, WS_BAR_BYTES, stream) != hipSuccess) { fprintf(stderr, "kernel_launch: memset of the barrier words failed\n"); return; }
    a.ph_lo = 0; a.ph_hi = N_PHASES;
    void* kargs[] = {&a};
    const hipError_t e = hipLaunchCooperativeKernel((const void*)fwd_kernel, dim3(grid), dim3(NTHREADS), kargs, LDS_BYTES, stream);
    if (e != hipSuccess) fprintf(stderr, "kernel_launch: cooperative launch failed: %s (grid %d)\n", hipGetErrorString(e), grid);
#endif
}
```
